# Optimizing an MI355X kernel written in HIP

```python
import math, functools
import jax, jax.numpy as jnp
from jax import lax
import numpy as np

D_MODEL = 1024
BATCH = 8
SEQ = 8192
DEPTH = 2

GRID_W = 64
CTX_LEN = 256
NORM_EPS = 1e-6
D_FF = 4 * D_MODEL
N_MOD = 6

SSD_HEADDIM = 64
SSD_HEADS = 16
SSD_INNER = SSD_HEADS * SSD_HEADDIM
SSD_GROUPS = 4
SSD_STATE = 128
SSD_CHUNK = 128
SSD_XBC = SSD_INNER + 2 * SSD_GROUPS * SSD_STATE
CONV_K = 3
GLA_HEADS = 8
GLA_DK = 64
GLA_DV = 128
GLA_KEY = GLA_HEADS * GLA_DK
GLA_VAL = GLA_HEADS * GLA_DV
GLA_GATE_RANK = 16
GLA_GATE_NORM = 16.0
HGRN_HEADS = 8
HGRN_DK = 128
HGRN_DV = 128
HGRN_WIDTH = HGRN_HEADS * HGRN_DV
S5_GROUP = 16
S5_GROUPS = 24
S5_WIDTH = S5_GROUPS * S5_GROUP
S5_STATE = 64
LIN_CHUNK = 64

EVEN_SPLITS = (SSD_INNER, SSD_XBC, 2 * SSD_HEADS, GLA_KEY, GLA_KEY, GLA_VAL, 2 * GLA_GATE_RANK, GLA_VAL)
ODD_SPLITS = (HGRN_WIDTH, HGRN_WIDTH, 2 * HGRN_WIDTH, HGRN_WIDTH, S5_WIDTH)
EVEN_IN = sum(EVEN_SPLITS)
ODD_IN = sum(ODD_SPLITS)
EVEN_MIX = SSD_INNER + GLA_VAL
ODD_MIX = HGRN_WIDTH + S5_WIDTH

kernel_name = 'hybrid_ssd_gla_hgrn2_s5_dit'


def _split(a, sizes):
    idx = np.cumsum(sizes)[:-1].tolist()
    return jnp.split(a, idx, axis=-1)


def rmsnorm(x, w):
    xf = x.astype(jnp.float32)
    y = xf * lax.rsqrt(jnp.mean(xf * xf, axis=-1, keepdims=True) + NORM_EPS)
    return (y * w.astype(jnp.float32)).astype(x.dtype)


def modulate(h, shift, scale):
    return h * (1.0 + scale) + shift


def sq_relu_mlp(h, w1, w2):
    return jnp.square(jax.nn.relu(h @ w1)) @ w2


def conv_grid(u, w, b, rows):
    bn, t, ch = u.shape
    img = u.reshape(bn, rows, GRID_W, ch)
    out = lax.conv_general_dilated(img, w[:, :, None, :], window_strides=(1, 1), padding='SAME',
                                   dimension_numbers=('NHWC', 'HWIO', 'NHWC'), feature_group_count=ch)
    return out.reshape(bn, t, ch) + b


def conv_seq(u, w, b):
    ch = u.shape[-1]
    out = lax.conv_general_dilated(u, w[:, None, :], window_strides=(1,), padding='SAME',
                                   dimension_numbers=('NWC', 'WIO', 'NWC'), feature_group_count=ch)
    return out + b


def ssd_chunk_scan(xdt, la, bm, cm, s0):
    f32 = jnp.float32
    bn, t, nh, p = xdt.shape
    g, n = bm.shape[-2:]
    r = nh // g
    c = SSD_CHUNK
    nc = t // c
    xc = xdt.astype(f32).reshape(bn, nc, c, g, r, p).transpose(1, 0, 3, 4, 2, 5)
    ac = la.astype(f32).reshape(bn, nc, c, g, r).transpose(1, 0, 3, 4, 2)
    bc = bm.astype(f32).reshape(bn, nc, c, g, n).transpose(1, 0, 3, 2, 4)
    cc = cm.astype(f32).reshape(bn, nc, c, g, n).transpose(1, 0, 3, 2, 4)
    lower = jnp.tril(jnp.ones((c, c), dtype=bool))

    def step(h, inp):
        xi, ai, bi, ci = inp
        acum = jnp.cumsum(ai, axis=-1)
        seg = jnp.where(lower, acum[..., :, None] - acum[..., None, :], -jnp.inf)
        scores = jnp.einsum('bgin,bgjn->bgij', ci, bi)[:, :, None] * jnp.exp(seg)
        y = jnp.einsum('bgrij,bgrjp->bgrip', scores, xi)
        y = y + jnp.einsum('bgin,bgrpn->bgrip', ci, h) * jnp.exp(acum)[..., None]
        xw = xi * jnp.exp(acum[..., -1:] - acum)[..., None]
        h = h * jnp.exp(acum[..., -1])[..., None, None] + jnp.einsum('bgjn,bgrjp->bgrpn', bi, xw)
        return h, y

    h, y = lax.scan(step, s0.astype(f32).reshape(bn, g, r, p, n), (xc, ac, bc, cc))
    y = y.transpose(1, 0, 4, 2, 3, 5).reshape(bn, t, nh, p)
    return y, h.reshape(bn, nh, p, n)


def gla_chunk_scan(q, k, v, lg, s0):
    f32 = jnp.float32
    bn, t, nh, dk = q.shape
    dv = v.shape[-1]
    nc = t // LIN_CHUNK

    def chunks(a):
        return a.astype(f32).reshape(bn, nc, LIN_CHUNK, nh, a.shape[-1]).transpose(1, 0, 3, 2, 4)

    lower = jnp.tril(jnp.ones((LIN_CHUNK, LIN_CHUNK), dtype=bool))

    def step(s, inp):
        qi, ki, vi, gi = inp
        gcum = jnp.cumsum(gi, axis=-2)
        glast = gcum[..., -1:, :]
        q_dec = qi * jnp.exp(gcum)
        k_inv = ki * jnp.exp(-gcum)
        att = jnp.where(lower, jnp.einsum('bhid,bhjd->bhij', q_dec, k_inv), 0.0)
        o = jnp.einsum('bhij,bhjv->bhiv', att, vi) + jnp.einsum('bhid,bhdv->bhiv', q_dec, s)
        k_end = ki * jnp.exp(glast - gcum)
        s = s * jnp.exp(glast)[..., 0, :, None] + jnp.einsum('bhjd,bhjv->bhdv', k_end, vi)
        return s, o

    s, o = lax.scan(step, s0.astype(f32), (chunks(q), chunks(k), chunks(v), chunks(lg)))
    o = o.transpose(1, 0, 3, 2, 4).reshape(bn, t, nh, dv)
    return o, s


def _cplx_affine_combine(e1, e2):
    a1r, a1i, b1r, b1i = e1
    a2r, a2i, b2r, b2i = e2
    ar = a2r * a1r - a2i * a1i
    ai = a2r * a1i + a2i * a1r
    br = a2r * b1r - a2i * b1i + b2r
    bi = a2r * b1i + a2i * b1r + b2i
    return ar, ai, br, bi


def s5_dir_scan(u, state, lam_re, lam_im, bb_re, bb_im, c_re, c_im):
    t = u.shape[1]
    bu_re = jnp.einsum('gpc,btgc->btgp', bb_re, u)
    bu_im = jnp.einsum('gpc,btgc->btgp', bb_im, u)
    ar = jnp.broadcast_to(lam_re, (1, t) + lam_re.shape)
    ai = jnp.broadcast_to(lam_im, (1, t) + lam_im.shape)
    pr, pi, hr, hi = lax.associative_scan(_cplx_affine_combine, (ar, ai, bu_re, bu_im), axis=1)
    s_re, s_im = state
    hr = hr + pr * s_re[:, None] - pi * s_im[:, None]
    hi = hi + pr * s_im[:, None] + pi * s_re[:, None]
    y = jnp.einsum('gcp,btgp->btgc', c_re, hr) - jnp.einsum('gcp,btgp->btgc', c_im, hi)
    return y, (hr[:, -1], hi[:, -1])


def _bidirectional(scan_f, scan_b, ctx_f, lat_f, ctx_b, lat_b, state0):
    oc_f, sc_f = scan_f(*ctx_f, state0)
    ol_f, _ = scan_f(*lat_f, sc_f)
    oc_b, sc_b = scan_b(*[jnp.flip(a, 1) for a in ctx_b], state0)
    ol_b, _ = scan_b(*[jnp.flip(a, 1) for a in lat_b], sc_b)
    return oc_f + jnp.flip(oc_b, 1), ol_f + jnp.flip(ol_b, 1)


def mixer_ssd_gla(hl, hc, w_in, conv_w, conv_b, dt_bias, a_log, d_skip, ssd_norm_w,
                  gate_w, gate_b, gla_norm_w, w_out, need_ctx):
    f32 = jnp.float32
    bn = hl.shape[0]
    rows = hl.shape[1] // GRID_W
    neg_a = -jnp.exp(a_log.astype(f32))

    def project(h, conv):
        t = h.shape[1]
        z, xbc, dt, q, k, v, lr, r = _split(h @ w_in, EVEN_SPLITS)
        xbc = jax.nn.silu(conv(xbc))
        x, bm, cm = _split(xbc, (SSD_INNER, SSD_GROUPS * SSD_STATE, SSD_GROUPS * SSD_STATE))
        x = x.astype(f32).reshape(bn, t, SSD_HEADS, SSD_HEADDIM)
        bm = bm.reshape(bn, t, SSD_GROUPS, SSD_STATE)
        cm = cm.reshape(bn, t, SSD_GROUPS, SSD_STATE)
        dt = jax.nn.softplus(dt.astype(f32).reshape(bn, t, 2, SSD_HEADS) + dt_bias.astype(f32))
        la = dt * neg_a
        xdt = x[:, :, None] * dt[..., None]
        ssd_f = (xdt[:, :, 0], la[:, :, 0], bm, cm)
        ssd_b = (xdt[:, :, 1], la[:, :, 1], bm, cm)
        q = q.reshape(bn, t, GLA_HEADS, GLA_DK) * (GLA_DK ** -0.5)
        k = k.reshape(bn, t, GLA_HEADS, GLA_DK)
        v = v.reshape(bn, t, GLA_HEADS, GLA_DV)
        gk = jnp.einsum('btdr,drk->btdk', lr.reshape(bn, t, 2, GLA_GATE_RANK), gate_w) + gate_b
        gk = (jax.nn.log_sigmoid(gk.astype(f32)) / GLA_GATE_NORM).reshape(bn, t, 2, GLA_HEADS, GLA_DK)
        gla_f = (q, k, v, gk[:, :, 0])
        gla_b = (q, k, v, gk[:, :, 1])
        return z, x, r, ssd_f, ssd_b, gla_f, gla_b

    zl, xl, rl, sfl, sbl, gfl, gbl = project(hl, lambda u: conv_grid(u, conv_w, conv_b, rows))
    zc, xc, rc, sfc, sbc, gfc, gbc = project(hc, lambda u: conv_seq(u, conv_w[CONV_K // 2], conv_b))

    ssd_s0 = jnp.zeros((bn, SSD_HEADS, SSD_HEADDIM, SSD_STATE), f32)
    yc, yl = _bidirectional(ssd_chunk_scan, ssd_chunk_scan, sfc, sfl, sbc, sbl, ssd_s0)
    gla_s0 = jnp.zeros((bn, GLA_HEADS, GLA_DK, GLA_DV), f32)
    oc, ol = _bidirectional(gla_chunk_scan, gla_chunk_scan, gfc, gfl, gbc, gbl, gla_s0)

    def finish(y, x, z, o, r):
        t = z.shape[1]
        y = (y + d_skip.astype(f32)[:, None] * x).reshape(bn, t, SSD_INNER) * jax.nn.silu(z.astype(f32))
        y = rmsnorm(y.reshape(bn, t, SSD_GROUPS, -1), ssd_norm_w.reshape(SSD_GROUPS, -1)).reshape(bn, t, SSD_INNER)
        o = rmsnorm(o, gla_norm_w).reshape(bn, t, GLA_VAL) * jax.nn.silu(r.astype(f32))
        return jnp.concatenate([y, o], axis=-1).astype(hl.dtype) @ w_out

    out_l = finish(yl, xl, zl, ol, rl)
    out_c = finish(yc, xc, zc, oc, rc) if need_ctx else None
    return out_l, out_c


def mixer_hgrn_s5(hl, hc, w_in, lb, hgrn_norm_w, a_re, a_im, log_dt, b_re, b_im, c_re, c_im,
                  d_skip, glu_w, glu_b, w_out, need_ctx):
    f32 = jnp.float32
    bn = hl.shape[0]
    log_lb = jnp.log(lb).reshape(2, HGRN_HEADS, HGRN_DK)
    log_1mlb = jnp.log1p(-lb).reshape(2, HGRN_HEADS, HGRN_DK)
    are, aim = a_re.astype(f32), a_im.astype(f32)
    delta = jnp.exp(log_dt.astype(f32))[..., None]
    mag = jnp.exp(are * delta)
    lbar_re, lbar_im = mag * jnp.cos(aim * delta), mag * jnp.sin(aim * delta)
    den = are * are + aim * aim
    zr = ((lbar_re - 1.0) * are + lbar_im * aim) / den
    zi = (lbar_im * are - (lbar_re - 1.0) * aim) / den
    bre, bim = b_re.astype(f32), b_im.astype(f32)
    bb_re = zr[..., None] * bre - zi[..., None] * bim
    bb_im = zr[..., None] * bim + zi[..., None] * bre
    cre, cim = c_re.astype(f32), c_im.astype(f32)

    def project(h):
        t = h.shape[1]
        q, i, f, g, u = _split(h @ w_in, ODD_SPLITS)
        q = jax.nn.silu(q.astype(f32)).reshape(bn, t, HGRN_HEADS, HGRN_DK)
        v = i.astype(f32).reshape(bn, t, HGRN_HEADS, HGRN_DV)
        f = f.astype(f32).reshape(bn, t, 2, HGRN_HEADS, HGRN_DK)
        log_f = jnp.logaddexp(log_lb, log_1mlb + jax.nn.log_sigmoid(f))
        k = -jnp.expm1(log_f)
        hg_f = (q, k[:, :, 0], v, log_f[:, :, 0])
        hg_b = (q, k[:, :, 1], v, log_f[:, :, 1])
        u = u.astype(f32).reshape(bn, t, S5_GROUPS, S5_GROUP)
        return g, u, hg_f, hg_b

    gl, ul, hfl, hbl = project(hl)
    gc, uc, hfc, hbc = project(hc)

    hg_s0 = jnp.zeros((bn, HGRN_HEADS, HGRN_DK, HGRN_DV), f32)
    oc, ol = _bidirectional(gla_chunk_scan, gla_chunk_scan, hfc, hfl, hbc, hbl, hg_s0)

    s5_f = functools.partial(s5_dir_scan, lam_re=lbar_re[0], lam_im=lbar_im[0], bb_re=bb_re[0],
                             bb_im=bb_im[0], c_re=cre, c_im=cim)
    s5_b = functools.partial(s5_dir_scan, lam_re=lbar_re[1], lam_im=lbar_im[1], bb_re=bb_re[1],
                             bb_im=bb_im[1], c_re=cre, c_im=cim)
    s5_s0 = (jnp.zeros((bn, S5_GROUPS, S5_STATE), f32), jnp.zeros((bn, S5_GROUPS, S5_STATE), f32))
    yc, yl = _bidirectional(s5_f, s5_b, (uc,), (ul,), (uc,), (ul,), s5_s0)
    dsk = d_skip.astype(f32).reshape(S5_GROUPS, S5_GROUP)

    def finish(o, g, y, u):
        t = g.shape[1]
        o = rmsnorm(o, hgrn_norm_w).reshape(bn, t, HGRN_WIDTH) * jax.nn.silu(g.astype(f32))
        y = jax.nn.gelu((y + dsk * u).reshape(bn, t, S5_WIDTH))
        y = y * jax.nn.sigmoid(y @ glu_w.astype(f32) + glu_b.astype(f32))
        return jnp.concatenate([o, y], axis=-1).astype(hl.dtype) @ w_out

    out_l = finish(ol, gl, yl, ul)
    out_c = finish(oc, gc, yc, uc) if need_ctx else None
    return out_l, out_c


def setup_inputs(seed: int = 0) -> dict:
    key = jax.random.key(seed)
    ks = iter(jax.random.split(key, 40))
    f32 = jnp.float32

    def nrm(shape, s):
        return jax.random.normal(next(ks), shape, f32) * s

    def log_uniform(shape, lo, hi):
        return jax.random.uniform(next(ks), shape, f32, minval=math.log(lo), maxval=math.log(hi))

    n_even, n_odd = (DEPTH + 1) // 2, DEPTH // 2
    dt0 = jnp.exp(log_uniform((n_even, 2, SSD_HEADS), 1e-3, 1e-1))
    n_idx = jnp.arange(S5_STATE, dtype=f32)
    return {
        'x': nrm((BATCH, SEQ, D_MODEL), 1.0),
        'c': nrm((BATCH, D_MODEL), 1.0),
        'ctx': nrm((BATCH, CTX_LEN, D_MODEL), 1.0),
        'c_ctx': nrm((D_MODEL,), 1.0),
        'ada_w': nrm((DEPTH, D_MODEL, N_MOD * D_MODEL), 0.5 * D_MODEL ** -0.5),
        'ada_b': nrm((DEPTH, N_MOD * D_MODEL), 0.02),
        'norm1_w': 1.0 + nrm((DEPTH, D_MODEL), 0.02),
        'norm2_w': 1.0 + nrm((DEPTH, D_MODEL), 0.02),
        'ssd_gla_w_in': nrm((n_even, D_MODEL, EVEN_IN), D_MODEL ** -0.5),
        'ssd_conv_w': nrm((n_even, CONV_K, CONV_K, SSD_XBC), 1.0 / CONV_K),
        'ssd_conv_b': nrm((n_even, SSD_XBC), 0.02),
        'ssd_dt_bias': dt0 + jnp.log(-jnp.expm1(-dt0)),
        'ssd_a_log': jnp.log(jax.random.uniform(next(ks), (n_even, 2, SSD_HEADS), f32, minval=1.0, maxval=16.0)),
        'ssd_d': 1.0 + nrm((n_even, SSD_HEADS), 0.1),
        'ssd_norm_w': 1.0 + nrm((n_even, SSD_INNER), 0.02),
        'gla_gate_w': nrm((n_even, 2, GLA_GATE_RANK, GLA_KEY), GLA_GATE_RANK ** -0.5),
        'gla_gate_b': nrm((n_even, 2, GLA_KEY), 0.1),
        'gla_norm_w': 1.0 + nrm((n_even, GLA_DV), 0.02),
        'ssd_gla_w_out': nrm((n_even, EVEN_MIX, D_MODEL), EVEN_MIX ** -0.5),
        'hgrn_s5_w_in': nrm((n_odd, D_MODEL, ODD_IN), D_MODEL ** -0.5),
        'hgrn_lb_logits': nrm((DEPTH, 2, HGRN_WIDTH), 0.1),
        'hgrn_norm_w': 1.0 + nrm((n_odd, HGRN_DV), 0.02),
        's5_a_re': -0.5 + nrm((n_odd, 2, S5_GROUPS, S5_STATE), 0.01),
        's5_a_im': math.pi * n_idx + nrm((n_odd, 2, S5_GROUPS, S5_STATE), 0.01),
        's5_log_dt': log_uniform((n_odd, 2, S5_GROUPS), 1e-3, 1e-1),
        's5_b_re': nrm((n_odd, S5_GROUPS, S5_STATE, S5_GROUP), (2 * S5_GROUP) ** -0.5),
        's5_b_im': nrm((n_odd, S5_GROUPS, S5_STATE, S5_GROUP), (2 * S5_GROUP) ** -0.5),
        's5_c_re': nrm((n_odd, S5_GROUPS, S5_GROUP, S5_STATE), (2 * S5_STATE) ** -0.5),
        's5_c_im': nrm((n_odd, S5_GROUPS, S5_GROUP, S5_STATE), (2 * S5_STATE) ** -0.5),
        's5_d': nrm((n_odd, S5_WIDTH), 1.0),
        's5_glu_w': nrm((n_odd, S5_WIDTH, S5_WIDTH), S5_WIDTH ** -0.5),
        's5_glu_b': nrm((n_odd, S5_WIDTH), 0.02),
        'hgrn_s5_w_out': nrm((n_odd, ODD_MIX, D_MODEL), ODD_MIX ** -0.5),
        'mlp_w1': nrm((DEPTH, D_MODEL, D_FF), D_MODEL ** -0.5),
        'mlp_w2': nrm((DEPTH, D_FF, D_MODEL), 0.5 * D_FF ** -0.5),
        'final_norm_w': 1.0 + nrm((D_MODEL,), 0.02),
    }


def reference(x, c, ctx, c_ctx, ada_w, ada_b, norm1_w, norm2_w,
              ssd_gla_w_in, ssd_conv_w, ssd_conv_b, ssd_dt_bias, ssd_a_log, ssd_d, ssd_norm_w,
              gla_gate_w, gla_gate_b, gla_norm_w, ssd_gla_w_out,
              hgrn_s5_w_in, hgrn_lb_logits, hgrn_norm_w, s5_a_re, s5_a_im, s5_log_dt,
              s5_b_re, s5_b_im, s5_c_re, s5_c_im, s5_d, s5_glu_w, s5_glu_b, hgrn_s5_w_out,
              mlp_w1, mlp_w2, final_norm_w):
    p_lb = jax.nn.softmax(hgrn_lb_logits.astype(jnp.float32), axis=0)
    lb_all = jnp.cumsum(p_lb, axis=0) - p_lb[0]
    xc = ctx
    for layer in range(DEPTH):
        need_ctx = layer < DEPTH - 1
        j = layer // 2
        mod_l = (jax.nn.silu(c) @ ada_w[layer] + ada_b[layer])[:, None, :]
        mod_c = (jax.nn.silu(c_ctx) @ ada_w[layer] + ada_b[layer])[None, None, :]
        sh1l, sc1l, g1l, sh2l, sc2l, g2l = jnp.split(mod_l, N_MOD, axis=-1)
        sh1c, sc1c, g1c, sh2c, sc2c, g2c = jnp.split(mod_c, N_MOD, axis=-1)
        hl = modulate(rmsnorm(x, norm1_w[layer]), sh1l, sc1l)
        hc = modulate(rmsnorm(xc, norm1_w[layer]), sh1c, sc1c)
        if layer % 2 == 0:
            ol, oc = mixer_ssd_gla(hl, hc, ssd_gla_w_in[j], ssd_conv_w[j], ssd_conv_b[j], ssd_dt_bias[j],
                                   ssd_a_log[j], ssd_d[j], ssd_norm_w[j], gla_gate_w[j], gla_gate_b[j],
                                   gla_norm_w[j], ssd_gla_w_out[j], need_ctx)
        else:
            ol, oc = mixer_hgrn_s5(hl, hc, hgrn_s5_w_in[j], lb_all[layer], hgrn_norm_w[j], s5_a_re[j],
                                   s5_a_im[j], s5_log_dt[j], s5_b_re[j], s5_b_im[j], s5_c_re[j], s5_c_im[j],
                                   s5_d[j], s5_glu_w[j], s5_glu_b[j], hgrn_s5_w_out[j], need_ctx)
        x = x + g1l * ol
        x = x + g2l * sq_relu_mlp(modulate(rmsnorm(x, norm2_w[layer]), sh2l, sc2l), mlp_w1[layer], mlp_w2[layer])
        if need_ctx:
            xc = xc + g1c * oc
            xc = xc + g2c * sq_relu_mlp(modulate(rmsnorm(xc, norm2_w[layer]), sh2c, sc2c),
                                        mlp_w1[layer], mlp_w2[layer])
    return rmsnorm(x, final_norm_w)
```

```cpp
#include <hip/hip_runtime.h>
#include <hip/hip_cooperative_groups.h>
#include <cstdio>
#include <cstdint>
namespace cg = cooperative_groups;

#ifndef MK_MODE
#define MK_MODE 0
#endif

#define LAS __attribute__((address_space(3)))
typedef unsigned short bf16_t;
typedef short bf16x8 __attribute__((ext_vector_type(8)));
typedef float f32x4 __attribute__((ext_vector_type(4)));
typedef float f32x2 __attribute__((ext_vector_type(2)));
typedef unsigned u32x4 __attribute__((ext_vector_type(4)));
typedef unsigned u32x2 __attribute__((ext_vector_type(2)));

constexpr int DM = 1024, NB = 8, TL = 8192, TC = 256;
constexpr int ML = NB * TL;
constexpr int MC = NB * TC;
constexpr int MT = ML + MC;
constexpr int CH = 32;
constexpr int NCH = (TC + TL) / CH;
constexpr int NCH_C = TC / CH;
constexpr int EVEN_IN = 6208, EVEN_PAD = 6400, ODD_IN = 5504, ODD_PAD = 5632;
constexpr float EPS = 1e-6f;
constexpr int C0_Z = 0, C0_XBC = 1024, C0_DT = 3072, C0_Q = 3104, C0_K = 3616, C0_V = 4128, C0_LR = 5152, C0_R = 5184;
constexpr int C0_Y = 1024, C0_O = 2048, C0_MIX = 3104;
constexpr int C1_Q = 0, C1_I = 1024, C1_F = 2048, C1_G = 4096, C1_U = 5120;

constexpr size_t OFF_WT_IN0 = 0;
constexpr size_t OFF_WT_OUT0 = OFF_WT_IN0 + (size_t)EVEN_PAD * 1024 * 2;
constexpr size_t OFF_WT_W1_0 = OFF_WT_OUT0 + 1024ull * 2048 * 2;
constexpr size_t OFF_WT_W2_0 = OFF_WT_W1_0 + 4096ull * 1024 * 2;
constexpr size_t OFF_WT_IN1 = OFF_WT_W2_0 + 4096ull * 1024 * 2;
constexpr size_t OFF_WT_OUT1 = OFF_WT_IN1 + (size_t)ODD_PAD * 1024 * 2;
constexpr size_t OFF_WT_W1_1 = OFF_WT_OUT1 + 1024ull * 1408 * 2;
constexpr size_t OFF_WT_W2_1 = OFF_WT_W1_1 + 4096ull * 1024 * 2;
constexpr size_t OFF_WT_GLU = OFF_WT_W2_1 + 4096ull * 1024 * 2;
constexpr size_t OFF_MOD = OFF_WT_GLU + 512ull * 384 * 2;
constexpr size_t OFF_XC = OFF_MOD + 2ull * 9 * 6144 * 4;
constexpr size_t OFF_H = OFF_XC + 2048ull * 1024 * 4;
constexpr size_t OFF_Z = OFF_H + (size_t)MT * 1024 * 2;
constexpr size_t WS_END = OFF_Z + (size_t)MT * EVEN_IN * 2;
constexpr size_t OFF_YS5 = OFF_Z + (size_t)MT * ODD_IN * 2;
constexpr size_t OFF_BAR = WS_END;
constexpr size_t WS_TOTAL = OFF_BAR + 3456 * 4;
static_assert(WS_TOTAL <= (1ull << 30), "workspace");
static_assert(OFF_YS5 + (size_t)ML * 384 * 2 <= WS_END, "ys5");
static_assert(OFF_MOD % 256 == 0 && OFF_XC % 256 == 0 && OFF_H % 256 == 0 && OFF_Z % 256 == 0 && OFF_YS5 % 16 == 0, "align");

constexpr int LDS_MAIN = 131072;
constexpr int LDS_BYTES = LDS_MAIN + 16;
constexpr int NPH = 20;

struct Params { const float* in[36]; float* out; unsigned char* ws; int ph_lo, ph_hi; };

typedef __bf16 bf16x2v __attribute__((ext_vector_type(2)));
__device__ __forceinline__ unsigned cvt_pk_bf16(float lo, float hi) { const f32x2 v = {lo, hi}; return __builtin_bit_cast(unsigned, __builtin_convertvector(v, bf16x2v)); }
__device__ __forceinline__ float bf2f(bf16_t u) { return __uint_as_float(((unsigned)u) << 16); }
__device__ __forceinline__ bf16_t f2bf(float f) { return (bf16_t)(cvt_pk_bf16(f, 0.f) & 0xffffu); }
__device__ __forceinline__ void unpack2(unsigned v, float& a, float& b) { a = __uint_as_float(v << 16); b = __uint_as_float(v & 0xffff0000u); }
__device__ __forceinline__ void unpack8(u32x4 v, float* f) { unpack2(v.x, f[0], f[1]); unpack2(v.y, f[2], f[3]); unpack2(v.z, f[4], f[5]); unpack2(v.w, f[6], f[7]); }
__device__ __forceinline__ u32x4 pack8(const float* f) { u32x4 r; r.x = cvt_pk_bf16(f[0], f[1]); r.y = cvt_pk_bf16(f[2], f[3]); r.z = cvt_pk_bf16(f[4], f[5]); r.w = cvt_pk_bf16(f[6], f[7]); return r; }
__device__ __forceinline__ float exp2f_(float x) { return __builtin_amdgcn_exp2f(x); }
__device__ __forceinline__ float sigmoidf_(float x) { return __builtin_amdgcn_rcpf(1.f + __expf(-x)); }
__device__ __forceinline__ float siluf_(float x) { return x * __builtin_amdgcn_rcpf(1.f + __expf(-x)); }
__device__ __forceinline__ float softplusf_(float x) { return x > 20.f ? x : log1pf(expf(x)); }
__device__ __forceinline__ float logsigmoidf_(float x) { return fminf(x, 0.f) - log1pf(expf(-fabsf(x))); }
__device__ __forceinline__ float gelu_tanh(float x) { const float u = 0.7978845608028654f * (x + 0.044715f * x * x * x); return 0.5f * x * (1.f + tanhf(u)); }
__device__ __forceinline__ float wave_sum(float v) {
#pragma unroll
    for (int o = 1; o < 64; o <<= 1) v += __shfl_xor(v, o);
    return v;
}
__device__ __forceinline__ int mod_idx(int r) { return r < ML ? (r >> 13) : 8; }
__device__ __forceinline__ int row_of(int b, int d, int s) {
    if (s < TC) { const int t = d ? (TC - 1 - s) : s; return ML + b * TC + t; }
    int t = s - TC; if (d) t = TL - 1 - t; return b * TL + t;
}
__device__ __forceinline__ bool first_arrival(int ci) { return ci < NCH_C ? (ci < NCH_C / 2) : ((ci - NCH_C) < (NCH - NCH_C) / 2); }

namespace pg8 {
constexpr int BM = 256, BK = 64, HALF = 128, HTB = HALF * BK * 2, STAGE_BYTES = 8 * HTB, NXCD = 8, WGM = 4;
__device__ __forceinline__ int lds_byte(int r, int c) { const int st = (r >> 4) * 2 + (c >> 5), rr = r & 15, cc = c & 31, ob = rr * 64 + cc * 2; return st * 1024 + (ob ^ (((ob >> 9) & 1) << 5)); }
__device__ __forceinline__ void stage_rc(int b, int& R, int& C) { const int st = b / 1024, sb = b % 1024, swz = sb ^ (((sb >> 9) & 1) << 5); R = (st >> 1) * 16 + swz / 64; C = (st & 1) * 32 + (swz % 64) / 2; }
__device__ __forceinline__ int perm32(int rho) { const int n = rho >> 4, i = rho & 15; return 8 * (i >> 2) + 4 * n + (i & 3); }
struct Unit { int pm, pn; };
struct StaticOrder {
    int nM, nN, nwg, G, c;
    __device__ void init(int M, int N, int G_, int c_) { nM = M / BM; nN = N / BM; nwg = nM * nN; G = G_; c = c_; }
    __device__ bool next(int i, Unit& u) const {
        const long L = (long)i * G + c; if (L >= nwg) return false;
        int wgid = (int)L; { const int q = nwg / NXCD, r = nwg % NXCD, xcd = wgid % NXCD, off = wgid / NXCD; wgid = (xcd < r ? xcd * (q + 1) : r * (q + 1) + (xcd - r) * q) + off; }
        const int nig = WGM * nN, gid = wgid / nig, fm = gid * WGM, gsz = (nM - fm) < WGM ? (nM - fm) : WGM;
        u.pm = fm + ((wgid % nig) % gsz); u.pn = (wgid % nig) / gsz; return true;
    }
};
template <class Epi>
__device__ __forceinline__ void gemm_phase(LAS unsigned char* lds, const bf16_t* A, int lda, const bf16_t* Bt, int M, int N, int K, const Epi& E) {
    StaticOrder S; S.init(M, N, (int)gridDim.x, (int)blockIdx.x);
    const int tid = threadIdx.x, wid = __builtin_amdgcn_readfirstlane(tid >> 6), lane = tid & 63, wr = wid >> 2, wc = wid & 3, fr = lane & 15, fq = lane >> 4;
    const int nt = K / BK;
    unsigned voffA[2], voffB[2];
#pragma unroll
    for (int i = 0; i < 2; ++i) { int R, C; stage_rc(tid * 16 + i * 8192, R, C); const int Rb = Epi::PERM ? ((R & ~31) + perm32(R & 31)) : R;
        voffA[i] = (unsigned)(R * lda + C) * 2u; voffB[i] = (unsigned)(Rb * K + C) * 2u; }
    const size_t kstep = (size_t)(BK * 2);
    const size_t hstepA = (size_t)HALF * lda * 2, hstepB = (size_t)HALF * K * 2;
    const size_t tstepA = 2 * hstepA, tstepB = 2 * hstepB;
    const unsigned ldsw = (unsigned)wid * 1024u;
    const int aoff = lds_byte(wr * 64 + fr, fq * 8), boff = lds_byte(wc * 32 + fr, fq * 8);
#define PG8_SA(b, h) (((b) * 2 + (h)) * HTB)
#define PG8_SB(b, h) ((4 + (b) * 2 + (h)) * HTB)
#define PG8_STAGE(bufoff, gbase, voff) do { _Pragma("unroll") for (int _i = 0; _i < 2; ++_i) \
        __builtin_amdgcn_global_load_lds((const unsigned*)((const char*)(gbase) + (voff)[_i]), (LAS unsigned*)(lds + (bufoff) + ldsw + _i * 8192), 16, 0, 0); } while (0)
#define PG8_LDA(dst, b, h) do { _Pragma("unroll") for (int m = 0; m < 4; ++m) _Pragma("unroll") for (int k = 0; k < 2; ++k) dst[m][k] = *(const LAS bf16x8*)(lds + PG8_SA(b, h) + aoff + m * 2048 + k * 1024); } while (0)
#define PG8_LDB(dst, b, h) do { _Pragma("unroll") for (int n = 0; n < 2; ++n) _Pragma("unroll") for (int k = 0; k < 2; ++k) dst[n][k] = *(const LAS bf16x8*)(lds + PG8_SB(b, h) + boff + n * 2048 + k * 1024); } while (0)
#define PG8_MMA(ai, bj, At, Bt_) do { __builtin_amdgcn_s_setprio(1); _Pragma("unroll") for (int m = 0; m < 4; ++m) _Pragma("unroll") for (int n = 0; n < 2; ++n) _Pragma("unroll") for (int k = 0; k < 2; ++k) \
        acc[ai][bj][m][n] = __builtin_amdgcn_mfma_f32_16x16x32_bf16(Bt_[n][k], At[m][k], acc[ai][bj][m][n], 0, 0, 0); __builtin_amdgcn_s_setprio(0); } while (0)
#define PG8_WAIT_V(n) asm volatile("s_waitcnt vmcnt(" #n ")" ::: "memory")
#define PG8_WAIT_L(n) asm volatile("s_waitcnt lgkmcnt(" #n ")" ::: "memory")
#define PG8_BAR __builtin_amdgcn_s_barrier()
#define PG8_SCHED __builtin_amdgcn_sched_barrier(0)
    Unit cur, nxt; int ui = 0;
    if (!S.next(0, cur)) return;
    f32x4 acc[2][2][4][2];
#pragma unroll
    for (int a = 0; a < 2; ++a)
#pragma unroll
        for (int b = 0; b < 2; ++b)
#pragma unroll
            for (int m = 0; m < 4; ++m)
#pragma unroll
                for (int n = 0; n < 2; ++n) acc[a][b][m][n] = (f32x4){0.f, 0.f, 0.f, 0.f};
    bf16x8 At[4][2], B0[2][2], B1[2][2];
    const char* cA = (const char*)A + (size_t)cur.pm * tstepA; const char* cB = (const char*)Bt + (size_t)cur.pn * tstepB;
    PG8_STAGE(PG8_SB(0, 0), cB, voffB); PG8_STAGE(PG8_SA(0, 0), cA, voffA); PG8_STAGE(PG8_SB(0, 1), cB + hstepB, voffB); PG8_STAGE(PG8_SA(0, 1), cA + hstepA, voffA);
    if (wr == 1) PG8_BAR;
    PG8_WAIT_V(4); PG8_BAR;
    PG8_STAGE(PG8_SB(1, 0), cB + kstep, voffB); PG8_STAGE(PG8_SA(1, 0), cA + kstep, voffA); PG8_STAGE(PG8_SB(1, 1), cB + hstepB + kstep, voffB);
    PG8_WAIT_V(6); PG8_BAR;
    for (;;) {
        const bool has_next = S.next(ui + 1, nxt);
        const char* nA = has_next ? (const char*)A + (size_t)nxt.pm * tstepA : cA; const char* nB = has_next ? (const char*)Bt + (size_t)nxt.pn * tstepB : cB;
#pragma nounroll
        for (int t = 0; t < nt; t += 2) {
            const bool last = (t == nt - 2);
            const char* a1 = cA + (size_t)(t + 1) * kstep;
            const char* a2 = last ? nA : cA + (size_t)(t + 2) * kstep; const char* b2 = last ? nB : cB + (size_t)(t + 2) * kstep;
            const char* a3 = a2 + kstep; const char* b3 = b2 + kstep;
            PG8_LDB(B0, 0, 0); PG8_SCHED; PG8_LDA(At, 0, 0); PG8_STAGE(PG8_SA(1, 1), a1 + hstepA, voffA);
            PG8_WAIT_L(8); PG8_BAR; PG8_WAIT_L(0); PG8_MMA(0, 0, At, B0); PG8_BAR; PG8_SCHED;
            PG8_LDB(B1, 0, 1); PG8_STAGE(PG8_SB(0, 0), b2, voffB);
            PG8_BAR; PG8_WAIT_L(0); PG8_MMA(0, 1, At, B1); PG8_BAR;
            PG8_LDA(At, 0, 1); PG8_STAGE(PG8_SA(0, 0), a2, voffA);
            PG8_BAR; PG8_WAIT_L(0); PG8_MMA(1, 0, At, B0); PG8_BAR; PG8_SCHED;
            PG8_STAGE(PG8_SB(0, 1), b2 + hstepB, voffB);
            PG8_WAIT_V(6); PG8_BAR; PG8_MMA(1, 1, At, B1); PG8_BAR;
            PG8_LDB(B0, 1, 0); PG8_SCHED; PG8_LDA(At, 1, 0); PG8_STAGE(PG8_SA(0, 1), a2 + hstepA, voffA);
            PG8_WAIT_L(8); PG8_BAR; PG8_WAIT_L(0); PG8_MMA(0, 0, At, B0); PG8_BAR; PG8_SCHED;
            PG8_LDB(B1, 1, 1); PG8_STAGE(PG8_SB(1, 0), b3, voffB);
            PG8_BAR; PG8_WAIT_L(0); PG8_MMA(0, 1, At, B1); PG8_BAR;
            PG8_LDA(At, 1, 1); PG8_STAGE(PG8_SA(1, 0), a3, voffA);
            PG8_BAR; PG8_WAIT_L(0); PG8_MMA(1, 0, At, B0); PG8_BAR; PG8_SCHED;
            PG8_STAGE(PG8_SB(1, 1), b3 + hstepB, voffB);
            PG8_WAIT_V(6); PG8_BAR; PG8_MMA(1, 1, At, B1); PG8_BAR;
        }
        E(acc, cur, wr, wc, fr, fq);
        if (!has_next) break;
#pragma unroll
        for (int a = 0; a < 2; ++a)
#pragma unroll
            for (int b = 0; b < 2; ++b)
#pragma unroll
                for (int m = 0; m < 4; ++m)
#pragma unroll
                    for (int n = 0; n < 2; ++n) acc[a][b][m][n] = (f32x4){0.f, 0.f, 0.f, 0.f};
        cur = nxt; cA = nA; cB = nB; ++ui;
    }
    PG8_WAIT_V(0);
    if (wr == 0) PG8_BAR;
    PG8_BAR;
#undef PG8_SA
#undef PG8_SB
#undef PG8_STAGE
#undef PG8_LDA
#undef PG8_LDB
#undef PG8_MMA
#undef PG8_WAIT_V
#undef PG8_WAIT_L
#undef PG8_BAR
#undef PG8_SCHED
}

template <int ACT  > struct EpiBf16 {
    static constexpr bool PERM = true;
    bf16_t* O; int ldc; int nvalid;
    __device__ __forceinline__ void operator()(const f32x4 (&acc)[2][2][4][2], const Unit& u, int wr, int wc, int fr, int fq) const {
        const int row0 = u.pm * BM + wr * 64 + fr, col0 = u.pn * BM + wc * 32 + 8 * fq;
#pragma unroll
        for (int ai = 0; ai < 2; ++ai)
#pragma unroll
            for (int m = 0; m < 4; ++m) { bf16_t* rowp = O + (size_t)(row0 + ai * HALF + m * 16) * ldc + col0;
#pragma unroll
                for (int bj = 0; bj < 2; ++bj) { if (col0 + bj * HALF < nvalid) { f32x4 v0 = acc[ai][bj][m][0], v1 = acc[ai][bj][m][1];
                    if (ACT == 1) {
#pragma unroll
                        for (int j = 0; j < 4; ++j) { const float a = fmaxf(v0[j], 0.f), b = fmaxf(v1[j], 0.f); v0[j] = a * a; v1[j] = b * b; } }
                    if (ACT == 2) { if (u.pn < 4) {
#pragma unroll
                        for (int j = 0; j < 4; ++j) { v0[j] = siluf_(v0[j]); v1[j] = siluf_(v1[j]); } } }
                    u32x4 w; w.x = cvt_pk_bf16(v0[0], v0[1]); w.y = cvt_pk_bf16(v0[2], v0[3]); w.z = cvt_pk_bf16(v1[0], v1[1]); w.w = cvt_pk_bf16(v1[2], v1[3]);
                    *(u32x4*)(rowp + bj * HALF) = w; } } }
    }
};
struct EpiResid {
    static constexpr bool PERM = false;
    const float* in_lat; const float* in_ctx; float* out_lat; float* out_ctx; const float* gate;
    __device__ __forceinline__ void operator()(const f32x4 (&acc)[2][2][4][2], const Unit& u, int wr, int wc, int fr, int fq) const {
        const int row0 = u.pm * BM + wr * 64 + fr, col0 = u.pn * BM + wc * 32 + 4 * fq;
#pragma unroll
        for (int ai = 0; ai < 2; ++ai)
#pragma unroll
            for (int m = 0; m < 4; ++m) { const int r = row0 + ai * HALF + m * 16;
                const float* ip = r < ML ? in_lat + (size_t)r * DM : in_ctx + (size_t)(r - ML) * DM;
                float* op = r < ML ? out_lat + (size_t)r * DM : out_ctx + (size_t)(r - ML) * DM;
                const float* gp = gate + mod_idx(r) * 6144;
#pragma unroll
                for (int bj = 0; bj < 2; ++bj)
#pragma unroll
                    for (int n = 0; n < 2; ++n) { const int c = col0 + bj * HALF + n * 16;
                        const f32x4 g = *(const f32x4*)(gp + c), x = *(const f32x4*)(ip + c);
                        *(f32x4*)(op + c) = x + g * acc[ai][bj][m][n]; } }
    }
};
struct EpiGlu {
    static constexpr bool PERM = true;
    const bf16_t* YG; bf16_t* Z1; const float* bias;
    __device__ __forceinline__ void operator()(const f32x4 (&acc)[2][2][4][2], const Unit& u, int wr, int wc, int fr, int fq) const {
        const int row0 = u.pm * BM + wr * 64 + fr, col0 = u.pn * BM + wc * 32 + 8 * fq;
#pragma unroll
        for (int ai = 0; ai < 2; ++ai)
#pragma unroll
            for (int m = 0; m < 4; ++m) { const int r = row0 + ai * HALF + m * 16;
#pragma unroll
                for (int bj = 0; bj < 2; ++bj) { const int c = col0 + bj * HALF; if (c < 384) {
#pragma unroll
                    for (int n = 0; n < 2; ++n) {
                        const u32x2 yv = *(const u32x2*)(YG + (size_t)r * 384 + c + 4 * n); float y0, y1, y2, y3; unpack2(yv.x, y0, y1); unpack2(yv.y, y2, y3);
                        const f32x4 b0 = *(const f32x4*)(bias + c + 4 * n); const f32x4 a = acc[ai][bj][m][n];
                        u32x2 w; w.x = cvt_pk_bf16(y0 * sigmoidf_(a[0] + b0[0]), y1 * sigmoidf_(a[1] + b0[1])); w.y = cvt_pk_bf16(y2 * sigmoidf_(a[2] + b0[2]), y3 * sigmoidf_(a[3] + b0[3]));
                        *(u32x2*)(Z1 + (size_t)r * ODD_IN + 1024 + c + 4 * n) = w; } } } }
    }
};
}

__device__ __forceinline__ void transpose_job(const float* W, int K, int N, bf16_t* WT, float* scr, int gw, int ngw, int lane) {
    const int nblk = N / 32, nitems = (K / 64) * nblk;
    for (int item = gw; item < nitems; item += ngw) {
        const int kb = item / nblk, nb = item % nblk, k0 = 64 * kb, n0 = 32 * nb;
#pragma unroll 8
        for (int i = 0; i < 32; ++i) { const int kk = 2 * i + (lane >> 5); scr[kk * 33 + (lane & 31)] = W[(size_t)(k0 + kk) * N + n0 + (lane & 31)]; }
        __builtin_amdgcn_wave_barrier(); asm volatile("s_waitcnt lgkmcnt(0)" ::: "memory");
        const int c = lane & 7;
#pragma unroll
        for (int j = 0; j < 4; ++j) { const int n = (lane >> 3) + 8 * j; const float* s = scr + (8 * c) * 33 + n;
            u32x4 o; o.x = cvt_pk_bf16(s[0 * 33], s[1 * 33]); o.y = cvt_pk_bf16(s[2 * 33], s[3 * 33]); o.z = cvt_pk_bf16(s[4 * 33], s[5 * 33]); o.w = cvt_pk_bf16(s[6 * 33], s[7 * 33]);
            *(u32x4*)(WT + (size_t)(n0 + n) * K + k0 + 8 * c) = o; }
        __builtin_amdgcn_wave_barrier(); asm volatile("s_waitcnt lgkmcnt(0)" ::: "memory");
    }
}
__device__ __forceinline__ void zero_rows(bf16_t* p, size_t nelem, int blk, int nblk) {
    const size_t n16 = nelem / 8; u32x4* q = (u32x4*)p;
    for (size_t i = (size_t)blk * 512 + threadIdx.x; i < n16; i += (size_t)nblk * 512) q[i] = (u32x4){0u, 0u, 0u, 0u};
}
__device__ __forceinline__ void phase_prep(const Params& p, unsigned char* smem) {
    const int tid = threadIdx.x, lane = tid & 63, wave = tid >> 6;
    const int gw = blockIdx.x * 8 + wave, ngw = gridDim.x * 8;
    float* scr = (float*)smem + wave * (64 * 33);
    unsigned char* ws = p.ws;
    transpose_job(p.in[8], 1024, EVEN_IN, (bf16_t*)(ws + OFF_WT_IN0), scr, gw, ngw, lane);
    zero_rows((bf16_t*)(ws + OFF_WT_IN0) + (size_t)EVEN_IN * 1024, (size_t)(EVEN_PAD - EVEN_IN) * 1024, blockIdx.x, gridDim.x);
    __syncthreads();
    float* sv = (float*)smem;
    float* red = sv + 9 * 1024;
    float* modp = (float*)(ws + OFF_MOD);
    bool sv_ready = false;
    for (int u = blockIdx.x; u < 192; u += gridDim.x) {
        if (!sv_ready) { for (int i = tid; i < 9 * 1024; i += 512) { const float cv = i < 8192 ? p.in[1][i] : p.in[3][i - 8192]; sv[i] = siluf_(cv); } sv_ready = true; }
        __syncthreads();
        const int layer = u / 96, c0 = (u % 96) * 64, kg = tid >> 6, col = tid & 63;
        float acc[9];
#pragma unroll
        for (int i = 0; i < 9; ++i) acc[i] = 0.f;
        const float* wp = p.in[4] + ((size_t)layer * 1024 + kg * 128) * 6144 + c0 + col;
#pragma unroll 4
        for (int kk = 0; kk < 128; ++kk) { const float w = wp[(size_t)kk * 6144];
#pragma unroll
            for (int i = 0; i < 9; ++i) acc[i] = fmaf(sv[i * 1024 + kg * 128 + kk], w, acc[i]); }
#pragma unroll
        for (int i = 0; i < 9; ++i) red[(kg * 9 + i) * 64 + col] = acc[i];
        __syncthreads();
        for (int o = tid; o < 9 * 64; o += 512) { const int i = o >> 6, cc = o & 63; float s = p.in[5][layer * 6144 + c0 + cc];
#pragma unroll
            for (int k2 = 0; k2 < 8; ++k2) s += red[(k2 * 9 + i) * 64 + cc];
            modp[((size_t)layer * 9 + i) * 6144 + c0 + cc] = s; }
        __syncthreads();
    }
}

template <bool FINAL>
__device__ __forceinline__ void phase_norm(const float* src_lat, const float* src_ctx, const float* nw, const float* mod_sh, const float* mod_sc, bf16_t* H, float* outf, int nrows) {
    const int lane = threadIdx.x & 63, gw = blockIdx.x * 8 + (threadIdx.x >> 6), ngw = gridDim.x * 8;
    constexpr int RW = 4;
    for (int r0 = gw * RW; r0 < nrows; r0 += ngw * RW) {
        f32x4 v[RW][4]; float ss[RW];
#pragma unroll
        for (int q = 0; q < RW; ++q) { const int r = r0 + q; const float* src = r < ML ? src_lat + (size_t)r * DM : src_ctx + (size_t)(r - ML) * DM;
#pragma unroll
            for (int j = 0; j < 4; ++j) v[q][j] = *(const f32x4*)(src + lane * 4 + 256 * j); }
#pragma unroll
        for (int q = 0; q < RW; ++q) { float s_ = 0.f;
#pragma unroll
            for (int j = 0; j < 4; ++j) s_ += v[q][j].x * v[q][j].x + v[q][j].y * v[q][j].y + v[q][j].z * v[q][j].z + v[q][j].w * v[q][j].w;
            ss[q] = s_; }
#pragma unroll
        for (int o = 1; o < 64; o <<= 1) {
#pragma unroll
            for (int q = 0; q < RW; ++q) ss[q] += __shfl_xor(ss[q], o); }
#pragma unroll
        for (int q = 0; q < RW; ++q) { const int r = r0 + q; const float rstd = rsqrtf(ss[q] * (1.f / DM) + EPS); const int mi = mod_idx(r);
#pragma unroll
            for (int j = 0; j < 4; ++j) { const int c = lane * 4 + 256 * j; const f32x4 w4 = *(const f32x4*)(nw + c); f32x4 y = v[q][j] * rstd * w4;
                if (FINAL) { *(f32x4*)(outf + (size_t)r * DM + c) = y; }
                else { const f32x4 sc = *(const f32x4*)(mod_sc + mi * 6144 + c), sh = *(const f32x4*)(mod_sh + mi * 6144 + c); y = y * (1.f + sc) + sh;
                    u32x2 o; o.x = cvt_pk_bf16(y.x, y.y); o.y = cvt_pk_bf16(y.z, y.w); *(u32x2*)(H + (size_t)r * DM + c) = o; } } }
    }
}

__device__ __forceinline__ void phase_conv(const Params& p) {
    const int tid = threadIdx.x, cgp = tid & 255, sub = tid >> 8, ch = cgp * 8;
    const bf16_t* Z = (const bf16_t*)(p.ws + OFF_Z);
    bf16_t* xl = (bf16_t*)p.out; bf16_t* xc = (bf16_t*)(p.ws + OFF_H);
    const float* cw = p.in[9]; const float* cb = p.in[10];
    float w[9][8], bias[8];
#pragma unroll
    for (int k = 0; k < 9; ++k)
#pragma unroll
        for (int i = 0; i < 8; ++i) w[k][i] = cw[k * 2048 + ch + i];
#pragma unroll
    for (int i = 0; i < 8; ++i) bias[i] = cb[ch + i];
    for (int q = blockIdx.x * 2 + sub; q < MT / 4; q += gridDim.x * 2) {
        const int r0 = q * 4;
        float acc[4][8];
#pragma unroll
        for (int o = 0; o < 4; ++o)
#pragma unroll
            for (int i = 0; i < 8; ++i) acc[o][i] = bias[i];
        const bool lat = r0 < ML;
        const int t0 = lat ? (r0 & (TL - 1)) : ((r0 - ML) & (TC - 1)), gy = t0 >> 6, gx0 = lat ? (t0 & 63) : t0, W = lat ? 64 : TC;
#pragma unroll
        for (int dy = -1; dy <= 1; ++dy) {
            if (dy != 0 && (!lat || gy + dy < 0 || gy + dy >= TL / 64)) continue;
            u32x4 v[6];
#pragma unroll
            for (int c = 0; c < 6; ++c) { const int gx = gx0 - 1 + c; v[c] = (gx >= 0 && gx < W) ? *(const u32x4*)(Z + (size_t)(r0 + dy * 64 - 1 + c) * EVEN_IN + C0_XBC + ch) : (u32x4){0u, 0u, 0u, 0u}; }
#pragma unroll
            for (int c = 0; c < 6; ++c) { float f[8]; unpack8(v[c], f);
#pragma unroll
                for (int o = 0; o < 4; ++o) { const int dx = c - 1 - o;
                    if (dx >= -1 && dx <= 1) {
#pragma unroll
                        for (int i = 0; i < 8; ++i) acc[o][i] = fmaf(f[i], w[(dy + 1) * 3 + dx + 1][i], acc[o][i]); } } }
        }
#pragma unroll
        for (int o = 0; o < 4; ++o) { const int r = r0 + o;
#pragma unroll
            for (int i = 0; i < 8; ++i) acc[o][i] = siluf_(acc[o][i]);
            bf16_t* dst = lat ? xl + (size_t)r * 2048 + ch : xc + (size_t)(r - ML) * 2048 + ch;
            *(u32x4*)dst = pack8(acc[o]); }
    }
}

__device__ __forceinline__ void lds_barrier() { asm volatile("s_waitcnt lgkmcnt(0)\n\ts_barrier" ::: "memory"); }
typedef short s16x4 __attribute__((ext_vector_type(4)));
__device__ __forceinline__ bf16x8 tr2(const bf16_t* p0, const bf16_t* p1) {
    const s16x4 a = __builtin_amdgcn_ds_read_tr16_b64_v4i16((LAS s16x4*)p0), b = __builtin_amdgcn_ds_read_tr16_b64_v4i16((LAS s16x4*)p1);
    return __builtin_shufflevector(a, b, 0, 1, 2, 3, 4, 5, 6, 7);
}
template <int MIX> struct MixCfg;
template <> struct MixCfg<0> { static constexpr int DK = 128, DV = 64; static constexpr bool SC = true; };
template <> struct MixCfg<1> { static constexpr int DK = 64, DV = 128; static constexpr bool SC = false; };
template <> struct MixCfg<2> { static constexpr int DK = 128, DV = 128; static constexpr bool SC = false; };
__device__ __forceinline__ bf16x8 tr_read8(unsigned a0, unsigned a1) {
    u32x2 lo, hi;
    asm volatile("ds_read_b64_tr_b16 %0, %2\n\tds_read_b64_tr_b16 %1, %3\n\ts_waitcnt lgkmcnt(0)" : "=&v"(lo), "=&v"(hi) : "v"(a0), "v"(a1) : "memory");
    u32x4 r; r.x = lo.x; r.y = lo.y; r.z = hi.x; r.w = hi.y; return __builtin_bit_cast(bf16x8, r);
}
template <int O0, int O1, int O2, int O3>
__device__ __forceinline__ void tr_read_x4(unsigned base, u32x2& d0, u32x2& d1, u32x2& d2, u32x2& d3) {
    asm volatile("ds_read_b64_tr_b16 %0, %4 offset:%5\n\tds_read_b64_tr_b16 %1, %4 offset:%6\n\tds_read_b64_tr_b16 %2, %4 offset:%7\n\tds_read_b64_tr_b16 %3, %4 offset:%8\n\ts_waitcnt lgkmcnt(0)"
                 : "=&v"(d0), "=&v"(d1), "=&v"(d2), "=&v"(d3) : "v"(base), "i"(O0), "i"(O1), "i"(O2), "i"(O3) : "memory");
}
template <int O0, int O1, int O2, int O3, int O4, int O5, int O6, int O7>
__device__ __forceinline__ void tr_read_x8(unsigned base, u32x2& d0, u32x2& d1, u32x2& d2, u32x2& d3, u32x2& d4, u32x2& d5, u32x2& d6, u32x2& d7) {
    asm volatile("ds_read_b64_tr_b16 %0, %8 offset:%9\n\tds_read_b64_tr_b16 %1, %8 offset:%10\n\tds_read_b64_tr_b16 %2, %8 offset:%11\n\tds_read_b64_tr_b16 %3, %8 offset:%12\n\t"
                 "ds_read_b64_tr_b16 %4, %8 offset:%13\n\tds_read_b64_tr_b16 %5, %8 offset:%14\n\tds_read_b64_tr_b16 %6, %8 offset:%15\n\tds_read_b64_tr_b16 %7, %8 offset:%16\n\ts_waitcnt lgkmcnt(0)"
                 : "=&v"(d0), "=&v"(d1), "=&v"(d2), "=&v"(d3), "=&v"(d4), "=&v"(d5), "=&v"(d6), "=&v"(d7)
                 : "v"(base), "i"(O0), "i"(O1), "i"(O2), "i"(O3), "i"(O4), "i"(O5), "i"(O6), "i"(O7) : "memory");
}
__device__ __forceinline__ bf16x8 mk8(u32x2 lo, u32x2 hi) { u32x4 r; r.x = lo.x; r.y = lo.y; r.z = hi.x; r.w = hi.y; return __builtin_bit_cast(bf16x8, r); }
template <int MIX>
__device__ __forceinline__ void chunk_item(const Params& p, unsigned char* smem, int item) {
    using Cfg = MixCfg<MIX>;
    constexpr int DK = Cfg::DK, DV = Cfg::DV; constexpr bool SC = Cfg::SC;
    constexpr int QS = DK + 8, VS = DV + 8, NPT = DV / 64, NKS = DK / 32, NNS = DK / 16;
    constexpr int DIRB = (3 * 32 * QS + 32 * VS) * 2 + 32 * DK * 4 + DK * 4 + 4608;
    static_assert(2 * DIRB <= LDS_MAIN, "lds");
    const int tid = threadIdx.x, d = tid >> 8, gt = tid & 255, t_ = gt >> 3, j_ = gt & 7;
    const int w = (tid >> 6) & 3, lane = tid & 63, r16 = lane & 15, quad = lane >> 4;
    unsigned char* L = smem + d * DIRB;
    bf16_t* Qt = (bf16_t*)L; bf16_t* Kt = Qt + 32 * QS; bf16_t* Kh = Kt + 32 * QS; bf16_t* Vs = Kh + 32 * QS;
    float* Gf = (float*)(Vs + 32 * VS); float* dC = Gf + 32 * DK; float* misc = dC + DK;
    const unsigned kh_addr = (unsigned)(size_t)Kh, vs_addr = (unsigned)(size_t)Vs;
    const int b = MIX == 0 ? (item >> 4) : (item >> 3), hd = MIX == 0 ? (item & 15) : (item & 7), g = hd >> 2;
    bf16_t* Z = (bf16_t*)(p.ws + OFF_Z);
    const bf16_t* xl = (const bf16_t*)p.out; const bf16_t* xcx = (const bf16_t*)(p.ws + OFF_H);
    bf16_t* Ob = (bf16_t*)(p.ws + OFF_H);
    float dtb = 0.f, nega = 0.f, dsk = 0.f, dt_ = 0.f;
    if constexpr (MIX == 0) { dtb = p.in[11][d * 16 + hd]; nega = -expf(p.in[12][d * 16 + hd]) * 1.4426950408889634f; dsk = p.in[13][hd]; }
    __syncthreads();
    bf16x8 gwB = (bf16x8){0, 0, 0, 0, 0, 0, 0, 0}; float gbl = 0.f;
    if constexpr (MIX == 1) { float hi_[8];
#pragma unroll
        for (int j = 0; j < 8; ++j) { const float v = p.in[15][((size_t)d * 16 + (quad & 1) * 8 + j) * 512 + hd * 64 + 16 * w + r16]; const float vh = bf2f(f2bf(v)); hi_[j] = quad < 2 ? vh : v - vh; }
        const u32x4 pk = pack8(hi_); gwB = __builtin_bit_cast(bf16x8, pk); gbl = p.in[16][d * 512 + hd * 64 + 16 * w + r16]; }
    if constexpr (MIX == 2) { if (gt < 128) { const float l0 = p.in[20][d * 1024 + hd * 128 + gt], l1 = p.in[20][2048 + d * 1024 + hd * 128 + gt]; misc[gt] = 1.f / (1.f + expf(l0 - l1)); } }
    __syncthreads();
    f32x4 accS[NNS][NPT];
#pragma unroll
    for (int a = 0; a < NNS; ++a)
#pragma unroll
        for (int i = 0; i < NPT; ++i) accS[a][i] = (f32x4){0.f, 0.f, 0.f, 0.f};
    u32x4 R0, R1, R2, R3, R4, R5; bf16_t rdt = 0;
    u32x4 kst0 = (u32x4){0u, 0u, 0u, 0u}, kst1 = kst0;
    R0 = R1 = R2 = R3 = R4 = R5 = (u32x4){0u, 0u, 0u, 0u};
#define LD16(base, off) (*(const u32x4*)((const char*)(base) + (unsigned)(off)))
    const unsigned cA = MIX == 0 ? (hd * 64 + j_ * 8) * 2u : (MIX == 1 ? (C0_V + hd * 128 + j_ * 16) * 2u : (C1_I + hd * 128 + j_ * 16) * 2u);
    const unsigned cB = MIX == 0 ? (1024 + g * 128 + j_ * 16) * 2u : (MIX == 1 ? (C0_K + hd * 64 + j_ * 8) * 2u : (C1_Q + hd * 128 + j_ * 16) * 2u);
    const unsigned cC = MIX == 0 ? (1536 + g * 128 + j_ * 16) * 2u : (MIX == 1 ? (C0_Q + hd * 64 + j_ * 8) * 2u : (C1_F + d * 1024 + hd * 128 + j_ * 16) * 2u);
    const unsigned cD = MIX == 0 ? (C0_DT + d * 16 + hd) * 2u : (C0_LR + d * 16 + (quad & 1) * 8) * 2u;
#define CK_LOAD(ci) do { const int r_ = row_of(b, d, (ci) * CH + t_); \
        if constexpr (MIX == 0) { const bool lat_ = (ci) >= NCH_C; const char* xb_ = lat_ ? (const char*)xl : (const char*)xcx - (size_t)ML * 4096; const unsigned xo_ = (unsigned)r_ * 4096u; \
            R0 = LD16(xb_, xo_ + cA); R1 = LD16(xb_, xo_ + cB); R2 = LD16(xb_, xo_ + cB + 16u); R3 = LD16(xb_, xo_ + cC); R4 = LD16(xb_, xo_ + cC + 16u); \
            rdt = *(const bf16_t*)((const char*)Z + ((unsigned)r_ * (EVEN_IN * 2u) + cD)); } \
        if constexpr (MIX == 1) { const unsigned zo_ = (unsigned)r_ * (EVEN_IN * 2u); \
            R0 = LD16(Z, zo_ + cA); R1 = LD16(Z, zo_ + cA + 16u); R2 = LD16(Z, zo_ + cB); R3 = LD16(Z, zo_ + cC); \
            const int rb_ = row_of(b, d, (ci) * CH), ra_ = d ? rb_ - r16 : rb_ + r16, rc_ = d ? rb_ - 16 - r16 : rb_ + 16 + r16; \
            R4 = LD16(Z, (unsigned)ra_ * (EVEN_IN * 2u) + cD); R5 = LD16(Z, (unsigned)rc_ * (EVEN_IN * 2u) + cD); } \
        if constexpr (MIX == 2) { const unsigned zo_ = (unsigned)r_ * (ODD_IN * 2u); \
            R0 = LD16(Z, zo_ + cA); R1 = LD16(Z, zo_ + cA + 16u); R2 = LD16(Z, zo_ + cB); R3 = LD16(Z, zo_ + cB + 16u); R4 = LD16(Z, zo_ + cC); R5 = LD16(Z, zo_ + cC + 16u); } } while (0)
    CK_LOAD(0);
    for (int ci = 0; ci < NCH; ++ci) {
        if constexpr (MIX == 0) { dt_ = softplusf_(bf2f(rdt) + dtb); if (j_ == 0) Gf[t_] = dt_ * nega; }
        if constexpr (MIX == 1) {
            const f32x4 z4 = (f32x4){0.f, 0.f, 0.f, 0.f};
            const f32x4 g0 = __builtin_amdgcn_mfma_f32_16x16x32_bf16(__builtin_bit_cast(bf16x8, R4), gwB, z4, 0, 0, 0), g1 = __builtin_amdgcn_mfma_f32_16x16x32_bf16(__builtin_bit_cast(bf16x8, R5), gwB, z4, 0, 0, 0);
            float l0[4], l1[4];
#pragma unroll
            for (int j = 0; j < 4; ++j) { const float a0 = g0[j] + gbl, a1 = g1[j] + gbl;
                l0[j] = __builtin_amdgcn_logf(1.f + exp2f_(fminf(a0 * -1.4426950408889634f, 115.f))) * (-1.f / 16.f);
                l1[j] = __builtin_amdgcn_logf(1.f + exp2f_(fminf(a1 * -1.4426950408889634f, 115.f))) * (-1.f / 16.f); }
#pragma unroll
            for (int j = 1; j < 4; ++j) { l0[j] += l0[j - 1]; l1[j] += l1[j - 1]; }
            float i0 = l0[3], i1 = l1[3];
            { float u0 = __shfl_up(i0, 16), u1 = __shfl_up(i1, 16); if (quad >= 1) { i0 += u0; i1 += u1; }
              u0 = __shfl_up(i0, 32); u1 = __shfl_up(i1, 32); if (quad >= 2) { i0 += u0; i1 += u1; } }
            const float e0 = i0 - l0[3], tot0 = __shfl(i0, 48 + r16), e1 = i1 - l1[3] + tot0;
#pragma unroll
            for (int j = 0; j < 4; ++j) { Gf[(quad * 4 + j) * 64 + 16 * w + r16] = l0[j] + e0; Gf[(16 + quad * 4 + j) * 64 + 16 * w + r16] = l1[j] + e1; } }
        if constexpr (MIX == 2) { float f_[16]; unpack8(R4, f_); unpack8(R5, f_ + 8);
            float k1_[16];
#pragma unroll
            for (int i = 0; i < 16; ++i) { const float lb_ = misc[j_ * 16 + i], sg = sigmoidf_(f_[i]); k1_[i] = (1.f - lb_) * (1.f - sg); f_[i] = __logf(lb_ + (1.f - lb_) * sg); }
            kst0 = pack8(k1_); kst1 = pack8(k1_ + 8);
#pragma unroll
            for (int i = 0; i < 4; ++i) *(f32x4*)(Gf + t_ * 128 + j_ * 16 + 4 * i) = (f32x4){f_[4 * i], f_[4 * i + 1], f_[4 * i + 2], f_[4 * i + 3]}; }
        __syncthreads();
        const int rbase = row_of(b, d, ci * CH); const bool first = first_arrival(ci);
        constexpr int OLD_LD = MIX == 2 ? 1024 : EVEN_IN, OCOL = MIX == 0 ? C0_Y : (MIX == 1 ? C0_O : 0), HW = MIX == 0 ? 64 : 128;
        bf16_t* const obase = MIX == 2 ? Ob : Z;
        unsigned ooff[2][4]; float oldv[NPT][2][4];
#pragma unroll
        for (int tt = 0; tt < 2; ++tt)
#pragma unroll
            for (int j = 0; j < 4; ++j) { const int t = 16 * tt + quad * 4 + j, r = d ? rbase - t : rbase + t; ooff[tt][j] = (unsigned)r * OLD_LD + OCOL + hd * HW + w * NPT * 16 + r16; }
        if (!first) {
#pragma unroll
            for (int i = 0; i < NPT; ++i)
#pragma unroll
                for (int tt = 0; tt < 2; ++tt)
#pragma unroll
                    for (int j = 0; j < 4; ++j) oldv[i][tt][j] = bf2f(obase[ooff[tt][j] + i * 16]);
        } else if constexpr (MIX == 0) {
            const bf16_t* xb = rbase < ML ? xl : xcx - (size_t)ML * 2048;
#pragma unroll
            for (int tt = 0; tt < 2; ++tt)
#pragma unroll
                for (int j = 0; j < 4; ++j) { const int t = 16 * tt + quad * 4 + j, r = d ? rbase - t : rbase + t; oldv[0][tt][j] = dsk * bf2f(xb[(size_t)r * 2048 + hd * 64 + w * 16 + r16]); }
        } else {
#pragma unroll
            for (int i = 0; i < NPT; ++i)
#pragma unroll
                for (int tt = 0; tt < 2; ++tt)
#pragma unroll
                    for (int j = 0; j < 4; ++j) oldv[i][tt][j] = 0.f;
        }
        if constexpr (MIX == 0) { if (gt < 32) { float s_ = 0.f, mine = 0.f;
#pragma unroll 8
                for (int u = 0; u < 32; ++u) { s_ += Gf[u]; if (u == gt) mine = s_; }
                Gf[32 + gt] = mine; } }
        if constexpr (MIX == 2) { constexpr int TP = DK / 8;
            const int n_ = gt % DK, part = gt / DK; float gv[TP];
#pragma unroll
            for (int t = 0; t < TP; ++t) gv[t] = Gf[(part * TP + t) * DK + n_];
#pragma unroll
            for (int t = 1; t < TP; ++t) gv[t] += gv[t - 1];
#pragma unroll
            for (int t = 0; t < TP; ++t) Gf[(part * TP + t) * DK + n_] = gv[t]; }
        if constexpr (MIX != 1) __syncthreads();
        if constexpr (MIX == 0) { const float Gt = Gf[32 + t_], GC = Gf[63], eend = exp2f_(GC - Gt);
            *(u32x4*)(Qt + t_ * QS + j_ * 16) = R3; *(u32x4*)(Qt + t_ * QS + j_ * 16 + 8) = R4;
            *(u32x4*)(Kt + t_ * QS + j_ * 16) = R1; *(u32x4*)(Kt + t_ * QS + j_ * 16 + 8) = R2;
            float f_[16]; unpack8(R1, f_); unpack8(R2, f_ + 8);
#pragma unroll
            for (int i = 0; i < 16; ++i) f_[i] *= eend;
            *(u32x4*)(Kh + t_ * QS + j_ * 16) = pack8(f_); *(u32x4*)(Kh + t_ * QS + j_ * 16 + 8) = pack8(f_ + 8);
            unpack8(R0, f_);
#pragma unroll
            for (int i = 0; i < 8; ++i) f_[i] *= dt_;
            *(u32x4*)(Vs + t_ * VS + j_ * 8) = pack8(f_);
            if (gt == 0) dC[0] = exp2f_(GC); }
        if constexpr (MIX == 1) { float q_[8], k_[8], a_[8];
            const f32x4 g0 = *(const f32x4*)(Gf + t_ * 64 + j_ * 8), g1 = *(const f32x4*)(Gf + t_ * 64 + j_ * 8 + 4), e0 = *(const f32x4*)(Gf + 31 * 64 + j_ * 8), e1 = *(const f32x4*)(Gf + 31 * 64 + j_ * 8 + 4);
            unpack8(R3, q_); unpack8(R2, k_);
#pragma unroll
            for (int i = 0; i < 8; ++i) { const float G = i < 4 ? g0[i & 3] : g1[i & 3], GC = i < 4 ? e0[i & 3] : e1[i & 3];
                q_[i] = q_[i] * 0.125f * exp2f_(G); a_[i] = k_[i] * exp2f_(fminf(-G, 115.f));
                if (t_ == 31) dC[j_ * 8 + i] = exp2f_(GC); }
            *(u32x4*)(Qt + t_ * QS + j_ * 8) = pack8(q_); *(u32x4*)(Kt + t_ * QS + j_ * 8) = pack8(a_);
            *(u32x4*)(Vs + t_ * VS + j_ * 16) = R0; *(u32x4*)(Vs + t_ * VS + j_ * 16 + 8) = R1; }
        if constexpr (MIX == 2) { float q_[16], f_[16], a_[16], c_[16];
            unpack8(R2, q_); unpack8(R3, q_ + 8); unpack8(kst0, f_); unpack8(kst1, f_ + 8);
#pragma unroll
            for (int i = 0; i < 16; ++i) { const float P0 = Gf[15 * 128 + j_ * 16 + i], GC = P0 + Gf[31 * 128 + j_ * 16 + i], G = Gf[t_ * 128 + j_ * 16 + i] + (t_ >= 16 ? P0 : 0.f);
                const float kk = f_[i];
                q_[i] = siluf_(q_[i]) * __expf(G); a_[i] = kk * __expf(-G); c_[i] = kk * __expf(GC - G);
                if (t_ == 31) dC[j_ * 16 + i] = __expf(GC); }
            *(u32x4*)(Qt + t_ * QS + j_ * 16) = pack8(q_); *(u32x4*)(Qt + t_ * QS + j_ * 16 + 8) = pack8(q_ + 8);
            *(u32x4*)(Kt + t_ * QS + j_ * 16) = pack8(a_); *(u32x4*)(Kt + t_ * QS + j_ * 16 + 8) = pack8(a_ + 8);
            *(u32x4*)(Kh + t_ * QS + j_ * 16) = pack8(c_); *(u32x4*)(Kh + t_ * QS + j_ * 16 + 8) = pack8(c_ + 8);
            *(u32x4*)(Vs + t_ * VS + j_ * 16) = R0; *(u32x4*)(Vs + t_ * VS + j_ * 16 + 8) = R1; }
        if (ci + 1 < NCH) CK_LOAD(ci + 1);
        __syncthreads();
        const float* Gs = Gf + 32;
        u32x2 P[3];
#pragma unroll
        for (int tile = 0; tile < 3; ++tile) { const int tt = tile > 0 ? 1 : 0, st = tile == 2 ? 1 : 0;
            f32x4 acc = (f32x4){0.f, 0.f, 0.f, 0.f};
#pragma unroll
            for (int ks = 0; ks < NKS; ++ks) { const bf16x8 a = *(const bf16x8*)(Kt + (16 * st + r16) * QS + 32 * ks + quad * 8), bq = *(const bf16x8*)(Qt + (16 * tt + r16) * QS + 32 * ks + quad * 8);
                acc = __builtin_amdgcn_mfma_f32_16x16x32_bf16(a, bq, acc, 0, 0, 0); }
            const int tl = 16 * tt + r16, s0 = 16 * st + quad * 4;
            if constexpr (SC) { const float gtl = Gs[tl]; const f32x4 gs4 = *(const f32x4*)(Gs + s0);
#pragma unroll
                for (int j = 0; j < 4; ++j) acc[j] = (s0 + j <= tl) ? acc[j] * exp2f_(gtl - gs4[j]) : 0.f; }
            else {
#pragma unroll
                for (int j = 0; j < 4; ++j) acc[j] = (s0 + j <= tl) ? acc[j] : 0.f; }
            P[tile].x = cvt_pk_bf16(acc[0], acc[1]); P[tile].y = cvt_pk_bf16(acc[2], acc[3]); }
        bf16x8 vb[NPT], vb2[NPT];
#pragma unroll
        for (int i = 0; i < NPT; ++i) { const bf16_t* vA = Vs + (quad * 4 + (r16 >> 2)) * VS + (w * NPT + i) * 16 + 4 * (r16 & 3); const bf16_t* vB = Vs + (quad * 8 + (r16 >> 2)) * VS + (w * NPT + i) * 16 + 4 * (r16 & 3);
            vb[i] = tr2(vA, vA + 16 * VS); vb2[i] = tr2(vB, vB + 4 * VS); }
#pragma unroll
        for (int i = 0; i < NPT; ++i) {
            bf16x8 Sb8[NKS];
#pragma unroll
            for (int sl = 0; sl < NKS; ++sl) { u32x4 r; r.x = cvt_pk_bf16(accS[2 * sl][i][0], accS[2 * sl][i][1]); r.y = cvt_pk_bf16(accS[2 * sl][i][2], accS[2 * sl][i][3]);
                r.z = cvt_pk_bf16(accS[2 * sl + 1][i][0], accS[2 * sl + 1][i][1]); r.w = cvt_pk_bf16(accS[2 * sl + 1][i][2], accS[2 * sl + 1][i][3]); Sb8[sl] = __builtin_bit_cast(bf16x8, r); }
#pragma unroll
            for (int tt = 0; tt < 2; ++tt) {
                u32x4 a4; if (tt == 0) { a4.x = P[0].x; a4.y = P[0].y; a4.z = 0u; a4.w = 0u; } else { a4.x = P[1].x; a4.y = P[1].y; a4.z = P[2].x; a4.w = P[2].y; }
                f32x4 acc = __builtin_amdgcn_mfma_f32_16x16x32_bf16(__builtin_bit_cast(bf16x8, a4), vb[i], (f32x4){0.f, 0.f, 0.f, 0.f}, 0, 0, 0);
                f32x4 acc2 = SC ? (f32x4){0.f, 0.f, 0.f, 0.f} : acc;
#pragma unroll
                for (int sl = 0; sl < NKS; ++sl) { const u32x2 lo = *(const u32x2*)(Qt + (16 * tt + r16) * QS + 32 * sl + quad * 4), hi = *(const u32x2*)(Qt + (16 * tt + r16) * QS + 32 * sl + 16 + quad * 4);
                    u32x4 q4; q4.x = lo.x; q4.y = lo.y; q4.z = hi.x; q4.w = hi.y;
                    acc2 = __builtin_amdgcn_mfma_f32_16x16x32_bf16(__builtin_bit_cast(bf16x8, q4), Sb8[sl], acc2, 0, 0, 0); }
                if constexpr (SC) { const f32x4 g4 = *(const f32x4*)(Gs + 16 * tt + quad * 4);
#pragma unroll
                    for (int j = 0; j < 4; ++j) acc[j] = fmaf(exp2f_(g4[j]), acc2[j], acc[j]); }
                else acc = acc2;
#pragma unroll
                for (int j = 0; j < 4; ++j) obase[ooff[tt][j] + i * 16] = f2bf(acc[j] + oldv[i][tt][j]);
            }
        }
        { const bf16_t* kB = (SC ? Kh : Kt) + (quad * 8 + (r16 >> 2)) * QS + 4 * (r16 & 3);
#pragma unroll
            for (int ns = 0; ns < NNS; ++ns) { const bf16x8 ka = tr2(kB + 16 * ns, kB + 16 * ns + 4 * QS);
                f32x4 dc; if constexpr (SC) { const float e = dC[0]; dc = (f32x4){e, e, e, e}; } else dc = *(const f32x4*)(dC + 16 * ns + quad * 4);
#pragma unroll
                for (int i = 0; i < NPT; ++i) { if constexpr (SC) accS[ns][i] = __builtin_amdgcn_mfma_f32_16x16x32_bf16(ka, vb2[i], accS[ns][i] * dc, 0, 0, 0);
                    else accS[ns][i] = __builtin_amdgcn_mfma_f32_16x16x32_bf16(ka, vb2[i], accS[ns][i], 0, 0, 0) * dc; } } }
    }
#undef CK_LOAD
#undef LD16
}

__device__ __forceinline__ void hgrn8_item(const Params& p, unsigned char* smem, int item) {
    constexpr int DK = 128, DV = 128, QS = DK + 8, VS = DV + 8, NKS = DK / 32, NNS = DK / 16;
    const int tid = threadIdx.x, d = item & 1, hd = (item >> 1) & 7, b = item >> 4, t_ = tid >> 4, j_ = tid & 15;
    const int w = tid >> 6, lane = tid & 63, r16 = lane & 15, quad = lane >> 4;
    bf16_t* Qt = (bf16_t*)smem; bf16_t* Kt = Qt + 32 * QS; bf16_t* Kh = Kt + 32 * QS; bf16_t* Vs = Kh + 32 * QS;
    float* Gf = (float*)(Vs + 32 * VS); float* dC = Gf + 32 * DK; float* lbs = dC + DK;
    const unsigned kh_addr = (unsigned)(size_t)Kh, vs_addr = (unsigned)(size_t)Vs;
    bf16_t* Z1 = (bf16_t*)(p.ws + OFF_Z);
    __syncthreads();
    if (tid < 128) { const float l0 = p.in[20][d * 1024 + hd * 128 + tid], l1 = p.in[20][2048 + d * 1024 + hd * 128 + tid]; lbs[tid] = 1.f / (1.f + expf(l0 - l1)); }
    __syncthreads();
    f32x4 accS[NNS];
#pragma unroll
    for (int a = 0; a < NNS; ++a) accS[a] = (f32x4){0.f, 0.f, 0.f, 0.f};
    u32x4 Rv, Rq, Rf, kst = (u32x4){0u, 0u, 0u, 0u};
    const unsigned hO = (C1_F + d * 1024 + hd * 128 + w * 16 + r16) * 2u;
    const unsigned hV = (C1_I + hd * 128 + j_ * 8) * 2u, hQ = (C1_Q + hd * 128 + j_ * 8) * 2u, hF = (C1_F + d * 1024 + hd * 128 + j_ * 8) * 2u;
#define H8_LOAD(ci) do { const unsigned zo_ = (unsigned)row_of(b, d, (ci) * CH + t_) * (ODD_IN * 2u); \
        Rv = *(const u32x4*)((const char*)Z1 + (zo_ + hV)); Rq = *(const u32x4*)((const char*)Z1 + (zo_ + hQ)); Rf = *(const u32x4*)((const char*)Z1 + (zo_ + hF)); } while (0)
    H8_LOAD(0);
    for (int ci = 0; ci < NCH; ++ci) {
        { float f_[8], k1_[8]; unpack8(Rf, f_);
#pragma unroll
            for (int i = 0; i < 8; ++i) { const float lb_ = lbs[j_ * 8 + i], sg = sigmoidf_(f_[i]); k1_[i] = (1.f - lb_) * (1.f - sg); f_[i] = __builtin_amdgcn_logf(lb_ + (1.f - lb_) * sg); }
            kst = pack8(k1_);
            *(f32x4*)(Gf + t_ * 128 + j_ * 8) = (f32x4){f_[0], f_[1], f_[2], f_[3]}; *(f32x4*)(Gf + t_ * 128 + j_ * 8 + 4) = (f32x4){f_[4], f_[5], f_[6], f_[7]}; }
        __syncthreads();
        { const int n_ = tid & 127, part = tid >> 7; float gv[8];
#pragma unroll
            for (int t = 0; t < 8; ++t) gv[t] = Gf[(part * 8 + t) * DK + n_];
#pragma unroll
            for (int t = 1; t < 8; ++t) gv[t] += gv[t - 1];
#pragma unroll
            for (int t = 0; t < 8; ++t) Gf[(part * 8 + t) * DK + n_] = gv[t]; }
        __syncthreads();
        { float q_[8], k_[8], a_[8];
            f32x4 g0 = *(const f32x4*)(Gf + t_ * 128 + j_ * 8), g1 = *(const f32x4*)(Gf + t_ * 128 + j_ * 8 + 4), e0 = (f32x4){0.f, 0.f, 0.f, 0.f}, e1 = e0;
#pragma unroll
            for (int pp = 0; pp < 4; ++pp) { const f32x4 a0 = *(const f32x4*)(Gf + (pp * 8 + 7) * 128 + j_ * 8), a1 = *(const f32x4*)(Gf + (pp * 8 + 7) * 128 + j_ * 8 + 4);
                e0 = e0 + a0; e1 = e1 + a1; if (pp < (t_ >> 3)) { g0 = g0 + a0; g1 = g1 + a1; } }
            unpack8(Rq, q_); unpack8(kst, k_);
#pragma unroll
            for (int i = 0; i < 8; ++i) { const float G = i < 4 ? g0[i & 3] : g1[i & 3], GC = i < 4 ? e0[i & 3] : e1[i & 3];
                q_[i] = q_[i] * exp2f_(G); a_[i] = k_[i] * exp2f_(-G);
                if (t_ == 31) dC[j_ * 8 + i] = exp2f_(GC); }
            *(u32x4*)(Qt + t_ * QS + j_ * 8) = pack8(q_); *(u32x4*)(Kt + t_ * QS + j_ * 8) = pack8(a_);
            *(u32x4*)(Vs + t_ * VS + j_ * 8) = Rv; }
        if (ci + 1 < NCH) H8_LOAD(ci + 1);
        __syncthreads();
        u32x2 P[3];
#pragma unroll
        for (int tile = 0; tile < 3; ++tile) { const int tt = tile > 0 ? 1 : 0, st = tile == 2 ? 1 : 0;
            f32x4 acc = (f32x4){0.f, 0.f, 0.f, 0.f};
#pragma unroll
            for (int ks = 0; ks < NKS; ++ks) { const bf16x8 a = *(const bf16x8*)(Kt + (16 * st + r16) * QS + 32 * ks + quad * 8), bq = *(const bf16x8*)(Qt + (16 * tt + r16) * QS + 32 * ks + quad * 8);
                acc = __builtin_amdgcn_mfma_f32_16x16x32_bf16(a, bq, acc, 0, 0, 0); }
            const int tl = 16 * tt + r16, s0 = 16 * st + quad * 4;
#pragma unroll
            for (int j = 0; j < 4; ++j) acc[j] = (s0 + j <= tl) ? acc[j] : 0.f;
            P[tile].x = cvt_pk_bf16(acc[0], acc[1]); P[tile].y = cvt_pk_bf16(acc[2], acc[3]); }
        const int rbase = row_of(b, d, ci * CH);
        const bf16_t* vA = Vs + (quad * 4 + (r16 >> 2)) * VS + w * 16 + 4 * (r16 & 3); const bf16_t* vB = Vs + (quad * 8 + (r16 >> 2)) * VS + w * 16 + 4 * (r16 & 3);
        const bf16x8 vb = tr2(vA, vA + 16 * VS), vb2 = tr2(vB, vB + 4 * VS);
        bf16x8 Sb8[NKS];
#pragma unroll
        for (int sl = 0; sl < NKS; ++sl) { u32x4 r; r.x = cvt_pk_bf16(accS[2 * sl][0], accS[2 * sl][1]); r.y = cvt_pk_bf16(accS[2 * sl][2], accS[2 * sl][3]);
            r.z = cvt_pk_bf16(accS[2 * sl + 1][0], accS[2 * sl + 1][1]); r.w = cvt_pk_bf16(accS[2 * sl + 1][2], accS[2 * sl + 1][3]); Sb8[sl] = __builtin_bit_cast(bf16x8, r); }
#pragma unroll
        for (int tt = 0; tt < 2; ++tt) {
            u32x4 a4; if (tt == 0) { a4.x = P[0].x; a4.y = P[0].y; a4.z = 0u; a4.w = 0u; } else { a4.x = P[1].x; a4.y = P[1].y; a4.z = P[2].x; a4.w = P[2].y; }
            f32x4 acc = __builtin_amdgcn_mfma_f32_16x16x32_bf16(__builtin_bit_cast(bf16x8, a4), vb, (f32x4){0.f, 0.f, 0.f, 0.f}, 0, 0, 0);
#pragma unroll
            for (int sl = 0; sl < NKS; ++sl) { const u32x2 lo = *(const u32x2*)(Qt + (16 * tt + r16) * QS + 32 * sl + quad * 4), hi = *(const u32x2*)(Qt + (16 * tt + r16) * QS + 32 * sl + 16 + quad * 4);
                u32x4 q4; q4.x = lo.x; q4.y = lo.y; q4.z = hi.x; q4.w = hi.y;
                acc = __builtin_amdgcn_mfma_f32_16x16x32_bf16(__builtin_bit_cast(bf16x8, q4), Sb8[sl], acc, 0, 0, 0); }
#pragma unroll
            for (int j = 0; j < 4; ++j) { const int t = 16 * tt + quad * 4 + j, r = d ? rbase - t : rbase + t;
                *(bf16_t*)((char*)Z1 + ((unsigned)r * (ODD_IN * 2u) + hO)) = f2bf(acc[j]); }
        }
        { const bf16_t* kB = Kt + (quad * 8 + (r16 >> 2)) * QS + 4 * (r16 & 3);
#pragma unroll
            for (int ns = 0; ns < NNS; ++ns) { const bf16x8 ka = tr2(kB + 16 * ns, kB + 16 * ns + 4 * QS); const f32x4 dc = *(const f32x4*)(dC + 16 * ns + quad * 4);
                accS[ns] = __builtin_amdgcn_mfma_f32_16x16x32_bf16(ka, vb2, accS[ns], 0, 0, 0) * dc; } }
    }
#undef H8_LOAD
}

template <int n> __device__ __forceinline__ void ldv(const float* p, float* o) {
    if (n == 2) { const f32x2 v = *(const f32x2*)p; o[0] = v.x; o[1] = v.y; }
    else { const f32x4 v = *(const f32x4*)p; o[0] = v.x; o[1] = v.y; o[2] = v.z; o[3] = v.w;
        if (n == 8) { const f32x4 v2 = *(const f32x4*)(p + 4); o[4] = v2.x; o[5] = v2.y; o[6] = v2.z; o[7] = v2.w; } }
}
__device__ __forceinline__ void s5_item(const Params& p, unsigned char* smem, int bitem) {
    constexpr int XS = 136, XB = 32 * XS * 2;
    const int tid = threadIdx.x, lane = tid & 63, wave = tid >> 6, sq = wave & 3, role = wave >> 2, d = (sq >> 1) & 1, r16 = lane & 15, quad = lane >> 4;
    const int pair = bitem * 2 + (sq & 1), b = pair / 24, g = pair % 24;
    const bf16_t* Z1 = (const bf16_t*)(p.ws + OFF_Z);
    bf16_t* YS = d ? (bf16_t*)(p.ws + OFF_H) : (bf16_t*)(p.ws + OFF_YS5);
    unsigned char* xbase = smem + sq * 2 * XB;
    bf16x8* bAl = (bf16x8*)(smem + 8 * XB + sq * 8192);
    float lre = 0.f, lim = 0.f, xr = 0.f, xi = 0.f;
    bf16x8 cB[4];
#pragma unroll
    for (int ks = 0; ks < 4; ++ks) cB[ks] = (bf16x8){0, 0, 0, 0, 0, 0, 0, 0};
    __syncthreads();
    if (role == 0) {
        const float delta = expf(p.in[24][d * 24 + g]);
        float* ztab = (float*)xbase;
        { const float are = p.in[22][(d * 24 + g) * 64 + lane], aim = p.in[23][(d * 24 + g) * 64 + lane], mag = expf(are * delta); lre = mag * cosf(aim * delta); lim = mag * sinf(aim * delta);
            const float den = are * are + aim * aim; ztab[2 * lane] = ((lre - 1.f) * are + lim * aim) / den; ztab[2 * lane + 1] = (lim * are - (lre - 1.f) * aim) / den; }
        __builtin_amdgcn_wave_barrier();
#pragma unroll 1
        for (int pt = 0; pt < 8; ++pt) { const int pp = 16 * pt + r16, st = pp >> 1, part = pp & 1; float f[8];
            const float zr = ztab[2 * st], zi = ztab[2 * st + 1];
#pragma unroll
            for (int j = 0; j < 8; ++j) { const int c = (quad & 1) * 8 + j; const float br = p.in[25][((size_t)g * 64 + st) * 16 + c], bi = p.in[26][((size_t)g * 64 + st) * 16 + c];
                const float v = part ? (zr * bi + zi * br) : (zr * br - zi * bi); f[j] = quad < 2 ? v : 0.f; }
            const u32x4 pk = pack8(f); bAl[pt * 64 + lane] = __builtin_bit_cast(bf16x8, pk); }
    } else {
#pragma unroll
        for (int ks = 0; ks < 4; ++ks) { float f[8];
#pragma unroll
            for (int j = 0; j < 8; ++j) { const int k = ks * 32 + quad * 8 + j, st = k >> 1; f[j] = (k & 1) ? -p.in[28][((size_t)g * 16 + r16) * 64 + st] : p.in[27][((size_t)g * 16 + r16) * 64 + st]; }
            const u32x4 pk = pack8(f); cB[ks] = __builtin_bit_cast(bf16x8, pk); }
    }
    __syncthreads();
    u32x4 ru0 = (u32x4){0u, 0u, 0u, 0u}, ru1 = ru0;
#define S5_LOAD(ci) do { const int rb_ = row_of(b, d, (ci) * CH); const int r0_ = d ? rb_ - r16 : rb_ + r16, r1_ = d ? rb_ - 16 - r16 : rb_ + 16 + r16; \
        ru0 = *(const u32x4*)(Z1 + (size_t)r0_ * ODD_IN + C1_U + g * 16 + (quad & 1) * 8); ru1 = *(const u32x4*)(Z1 + (size_t)r1_ * ODD_IN + C1_U + g * 16 + (quad & 1) * 8); } while (0)
    if (role == 0) S5_LOAD(0);
    for (int it = 0; it <= NCH; ++it) {
        if (role == 0) {
            if (it < NCH) { const int ci = it; bf16_t* xs = (bf16_t*)(xbase + (ci & 1) * XB);
                const u32x4 z4 = (u32x4){0u, 0u, 0u, 0u};
                const bf16x8 u0 = __builtin_bit_cast(bf16x8, quad < 2 ? ru0 : z4), u1 = __builtin_bit_cast(bf16x8, quad < 2 ? ru1 : z4);
                if (ci + 1 < NCH) S5_LOAD(ci + 1);
                bf16x8 bAr[8];
#pragma unroll
                for (int pt = 0; pt < 8; ++pt) bAr[pt] = bAl[pt * 64 + lane];
#pragma unroll
                for (int pt = 0; pt < 8; ++pt) {
                    const f32x4 d0 = __builtin_amdgcn_mfma_f32_16x16x32_bf16(bAr[pt], u0, (f32x4){0.f, 0.f, 0.f, 0.f}, 0, 0, 0);
                    const f32x4 d1 = __builtin_amdgcn_mfma_f32_16x16x32_bf16(bAr[pt], u1, (f32x4){0.f, 0.f, 0.f, 0.f}, 0, 0, 0);
                    u32x2 w0, w1; w0.x = cvt_pk_bf16(d0[0], d0[1]); w0.y = cvt_pk_bf16(d0[2], d0[3]); w1.x = cvt_pk_bf16(d1[0], d1[1]); w1.y = cvt_pk_bf16(d1[2], d1[3]);
                    *(u32x2*)(xs + r16 * XS + 16 * pt + quad * 4) = w0; *(u32x2*)(xs + (16 + r16) * XS + 16 * pt + quad * 4) = w1; }
                __builtin_amdgcn_wave_barrier();
#pragma unroll 1
                for (int t8 = 0; t8 < CH; t8 += 8) { unsigned bv[8], xv[8];
#pragma unroll
                    for (int t = 0; t < 8; ++t) bv[t] = *(const unsigned*)(xs + (t8 + t) * XS + 2 * lane);
#pragma unroll
                    for (int t = 0; t < 8; ++t) { float br, bi; unpack2(bv[t], br, bi);
                        const float nr = fmaf(lre, xr, fmaf(-lim, xi, br)), ni = fmaf(lre, xi, fmaf(lim, xr, bi)); xr = nr; xi = ni; xv[t] = cvt_pk_bf16(xr, xi); }
#pragma unroll
                    for (int t = 0; t < 8; ++t) *(unsigned*)(xs + (t8 + t) * XS + 2 * lane) = xv[t]; }
            }
        } else {
            if (it >= 1) { const int ci = it - 1; const bf16_t* xs = (const bf16_t*)(xbase + (ci & 1) * XB);
                const int rbase = row_of(b, d, ci * CH);
                if (rbase < ML) {
#pragma unroll
                    for (int tile = 0; tile < 2; ++tile) {
                        f32x4 acc = (f32x4){0.f, 0.f, 0.f, 0.f};
#pragma unroll
                        for (int ks = 0; ks < 4; ++ks) { const bf16x8 a = *(const bf16x8*)(xs + (tile * 16 + r16) * XS + ks * 32 + quad * 8); acc = __builtin_amdgcn_mfma_f32_16x16x32_bf16(a, cB[ks], acc, 0, 0, 0); }
#pragma unroll
                        for (int j = 0; j < 4; ++j) { const int t = tile * 16 + quad * 4 + j, r = d ? rbase - t : rbase + t; *(bf16_t*)((char*)YS + ((unsigned)r * 768u + (unsigned)(g * 16 + r16) * 2u)) = f2bf(acc[j]); }
                    } }
            }
        }
        lds_barrier();
    }
#undef S5_LOAD
}

__device__ __forceinline__ void prep_late(const Params& p, unsigned char* smem, int blk, int nblk) {
    const int tid = threadIdx.x, lane = tid & 63, wave = tid >> 6, gw = blk * 8 + wave, ngw = nblk * 8;
    float* scr = (float*)smem + wave * (64 * 33);
    unsigned char* ws = p.ws;
    transpose_job(p.in[18], 2048, 1024, (bf16_t*)(ws + OFF_WT_OUT0), scr, gw, ngw, lane);
    transpose_job(p.in[33], 1024, 4096, (bf16_t*)(ws + OFF_WT_W1_0), scr, gw, ngw, lane);
    transpose_job(p.in[34], 4096, 1024, (bf16_t*)(ws + OFF_WT_W2_0), scr, gw, ngw, lane);
    transpose_job(p.in[19], 1024, ODD_IN, (bf16_t*)(ws + OFF_WT_IN1), scr, gw, ngw, lane);
    transpose_job(p.in[32], 1408, 1024, (bf16_t*)(ws + OFF_WT_OUT1), scr, gw, ngw, lane);
    transpose_job(p.in[33] + 1024 * 4096, 1024, 4096, (bf16_t*)(ws + OFF_WT_W1_1), scr, gw, ngw, lane);
    transpose_job(p.in[34] + 4096 * 1024, 4096, 1024, (bf16_t*)(ws + OFF_WT_W2_1), scr, gw, ngw, lane);
    transpose_job(p.in[30], 384, 384, (bf16_t*)(ws + OFF_WT_GLU), scr, gw, ngw, lane);
    zero_rows((bf16_t*)(ws + OFF_WT_IN1) + (size_t)ODD_IN * 1024, (size_t)(ODD_PAD - ODD_IN) * 1024, blk, nblk);
    zero_rows((bf16_t*)(ws + OFF_WT_GLU) + (size_t)384 * 384, (size_t)(512 - 384) * 384, blk, nblk);
}
__device__ __forceinline__ void phase_scan0(const Params& p, unsigned char* smem) {
    if ((int)gridDim.x > 192) { if ((int)blockIdx.x >= 192) prep_late(p, smem, (int)blockIdx.x - 192, (int)gridDim.x - 192); }
    else prep_late(p, smem, (int)blockIdx.x, (int)gridDim.x);
    for (int item = blockIdx.x; item < 192; item += gridDim.x) { if (item < 128) { const int x_ = item & 7, s_ = item >> 3, pr_ = x_ * 4 + (s_ >> 2);
            chunk_item<0>(p, smem, (pr_ >> 2) * 16 + (pr_ & 3) * 4 + (s_ & 3)); } else chunk_item<1>(p, smem, item - 128); __syncthreads(); }
}
__device__ __forceinline__ void phase_scan1(const Params& p, unsigned char* smem) {
    for (int item = blockIdx.x; item < 96 + 128; item += gridDim.x) { if (item < 96) s5_item(p, smem, item); else hgrn8_item(p, smem, item - 96); __syncthreads(); }
}

__device__ __forceinline__ void phase_finish0(const Params& p) {
    const int lane = threadIdx.x & 63, gw = blockIdx.x * 8 + (threadIdx.x >> 6), ngw = gridDim.x * 8;
    bf16_t* Z = (bf16_t*)(p.ws + OFF_Z);
    float nws[16], nwg[16];
#pragma unroll
    for (int i = 0; i < 16; ++i) { nws[i] = p.in[14][lane * 16 + i]; nwg[i] = p.in[17][(lane & 7) * 16 + i]; }
    for (int r0 = gw * 2; r0 < MT; r0 += ngw * 2) {
        u32x4 L[2][8];
#pragma unroll
        for (int q = 0; q < 2; ++q) { const bf16_t* zr = Z + (size_t)(r0 + q) * EVEN_IN;
            L[q][0] = *(const u32x4*)(zr + C0_Y + lane * 16); L[q][1] = *(const u32x4*)(zr + C0_Y + lane * 16 + 8);
            L[q][2] = *(const u32x4*)(zr + C0_Z + lane * 16); L[q][3] = *(const u32x4*)(zr + C0_Z + lane * 16 + 8);
            L[q][4] = *(const u32x4*)(zr + C0_O + lane * 16); L[q][5] = *(const u32x4*)(zr + C0_O + lane * 16 + 8);
            L[q][6] = *(const u32x4*)(zr + C0_R + lane * 16); L[q][7] = *(const u32x4*)(zr + C0_R + lane * 16 + 8); }
#pragma unroll
        for (int q = 0; q < 2; ++q) { bf16_t* zr = Z + (size_t)(r0 + q) * EVEN_IN;
            float y[16], z[16], o[16], rr[16];
            unpack8(L[q][0], y); unpack8(L[q][1], y + 8); unpack8(L[q][2], z); unpack8(L[q][3], z + 8);
            unpack8(L[q][4], o); unpack8(L[q][5], o + 8); unpack8(L[q][6], rr); unpack8(L[q][7], rr + 8);
            float s1 = 0.f, s2 = 0.f;
#pragma unroll
            for (int i = 0; i < 16; ++i) { y[i] *= siluf_(z[i]); s1 = fmaf(y[i], y[i], s1); s2 = fmaf(o[i], o[i], s2); }
            s1 += __shfl_xor(s1, 1); s1 += __shfl_xor(s1, 2); s1 += __shfl_xor(s1, 4); s1 += __shfl_xor(s1, 8);
            s2 += __shfl_xor(s2, 1); s2 += __shfl_xor(s2, 2); s2 += __shfl_xor(s2, 4);
            const float r1 = rsqrtf(s1 * (1.f / 256.f) + EPS), r2 = rsqrtf(s2 * (1.f / 128.f) + EPS);
#pragma unroll
            for (int i = 0; i < 16; ++i) { y[i] = y[i] * r1 * nws[i]; o[i] = o[i] * r2 * nwg[i] * siluf_(rr[i]); }
            *(u32x4*)(zr + C0_MIX + lane * 16) = pack8(y); *(u32x4*)(zr + C0_MIX + lane * 16 + 8) = pack8(y + 8);
            *(u32x4*)(zr + C0_MIX + 1024 + lane * 16) = pack8(o); *(u32x4*)(zr + C0_MIX + 1024 + lane * 16 + 8) = pack8(o + 8); }
    }
}
__device__ __forceinline__ void phase_finish1(const Params& p) {
    const int lane = threadIdx.x & 63, gw = blockIdx.x * 8 + (threadIdx.x >> 6), ngw = gridDim.x * 8;
    bf16_t* Z1 = (bf16_t*)(p.ws + OFF_Z);
    bf16_t* YS = (bf16_t*)(p.ws + OFF_YS5);
    float nwh[16], dsk[6];
#pragma unroll
    for (int i = 0; i < 16; ++i) nwh[i] = p.in[21][(lane & 7) * 16 + i];
#pragma unroll
    for (int i = 0; i < 6; ++i) dsk[i] = p.in[29][lane * 6 + i];
    for (int r = gw; r < ML; r += ngw) {
        bf16_t* zr = Z1 + (size_t)r * ODD_IN;
        float o[16], gg[16];
        { float ob[16]; unpack8(*(const u32x4*)(zr + C1_F + lane * 16), o); unpack8(*(const u32x4*)(zr + C1_F + lane * 16 + 8), o + 8);
            unpack8(*(const u32x4*)(zr + C1_F + 1024 + lane * 16), ob); unpack8(*(const u32x4*)(zr + C1_F + 1024 + lane * 16 + 8), ob + 8);
#pragma unroll
            for (int i = 0; i < 16; ++i) o[i] += ob[i]; }
        unpack8(*(const u32x4*)(zr + C1_G + lane * 16), gg); unpack8(*(const u32x4*)(zr + C1_G + lane * 16 + 8), gg + 8);
        float s2 = 0.f;
#pragma unroll
        for (int i = 0; i < 16; ++i) s2 = fmaf(o[i], o[i], s2);
        s2 += __shfl_xor(s2, 1); s2 += __shfl_xor(s2, 2); s2 += __shfl_xor(s2, 4);
        const float r2 = rsqrtf(s2 * (1.f / 128.f) + EPS);
#pragma unroll
        for (int i = 0; i < 16; ++i) o[i] = o[i] * r2 * nwh[i] * siluf_(gg[i]);
        unsigned* yp = (unsigned*)(YS + (size_t)r * 384 + lane * 6); const unsigned* up = (const unsigned*)(zr + C1_U + lane * 6);
        const unsigned* ybp = (const unsigned*)((const bf16_t*)(p.ws + OFF_H) + (size_t)r * 384 + lane * 6);
        float yv[6], uv[6];
#pragma unroll
        for (int i = 0; i < 3; ++i) { float b0, b1; unpack2(yp[i], yv[2 * i], yv[2 * i + 1]); unpack2(ybp[i], b0, b1); yv[2 * i] += b0; yv[2 * i + 1] += b1; unpack2(up[i], uv[2 * i], uv[2 * i + 1]); }
#pragma unroll
        for (int i = 0; i < 6; ++i) yv[i] = gelu_tanh(fmaf(dsk[i], uv[i], yv[i]));
#pragma unroll
        for (int i = 0; i < 3; ++i) yp[i] = cvt_pk_bf16(yv[2 * i], yv[2 * i + 1]);
        *(u32x4*)(zr + lane * 16) = pack8(o); *(u32x4*)(zr + lane * 16 + 8) = pack8(o + 8);
    }
}

#define XB_TMO      128
#define XB_XCNT(j)  (256  + 64 * (j))
#define XB_XSUB(j)  (1280 + 64 * (j))
#define XB_XGEN(j)  (2304 + 64 * (j))
#define XB_TOP      3328
#define XB_TOPGEN   3392
#define XCD_BAR_WORDS 3456
#define XB_SPIN_CAP (1u << 18)

__device__ __forceinline__ unsigned xb_ld(unsigned* p)              { return __hip_atomic_load(p, __ATOMIC_RELAXED, __HIP_MEMORY_SCOPE_AGENT); }
__device__ __forceinline__ unsigned xb_add(unsigned* p, unsigned v) { return __hip_atomic_fetch_add(p, v, __ATOMIC_RELAXED, __HIP_MEMORY_SCOPE_AGENT); }
__device__ __forceinline__ unsigned xb_xcc_id() { return (unsigned)__builtin_amdgcn_s_getreg((3 << 11) | 20) & 0xFu; }
#define XB_SPIN(cond, bar) do { unsigned _sp = 0; while (cond) { __builtin_amdgcn_s_sleep(1); \
    if ((++_sp & 255u) == 0u) { if (xb_ld(&(bar)[XB_TMO])) break; if (_sp > XB_SPIN_CAP) { atomicAdd(&(bar)[XB_TMO], 1u); break; } } } } while (0)

struct XcdBarrier {
    unsigned* bar; unsigned x;
    volatile LAS unsigned* st;
};

__device__ __forceinline__ XcdBarrier xcd_barrier_post(unsigned* bar, volatile LAS unsigned* st) {
    XcdBarrier b; b.bar = bar; b.x = xb_xcc_id(); b.st = st;
    if (threadIdx.x == 0) (void)xb_add(&bar[XB_XCNT(b.x)], 1u);
    return b;
}
__device__ __forceinline__ void xcd_barrier_complete(unsigned* bar, unsigned x, unsigned& nloc, unsigned& nx) {
    const unsigned G = gridDim.x * gridDim.y * gridDim.z;
    unsigned sum, cnt, mine, sp = 0u;
    for (;;) {
        sum = 0u; cnt = 0u; mine = 0u;
#pragma unroll
        for (unsigned j = 0; j < 16; ++j) { const unsigned c = xb_ld(&bar[XB_XCNT(j)]); sum += c; cnt += (c > 0u) ? 1u : 0u; mine = (j == x) ? c : mine; }
        if (sum == G) break;
        __builtin_amdgcn_s_sleep(1);
        if ((++sp & 255u) == 0u) { if (xb_ld(&bar[XB_TMO])) break; if (sp > XB_SPIN_CAP) { atomicAdd(&bar[XB_TMO], 1u); break; } }
    }
    nloc = mine > 0u ? mine : 1u; nx = cnt > 0u ? cnt : 1u;
}

__device__ __forceinline__ void xcd_barrier(const XcdBarrier& b) {
    asm volatile("s_waitcnt vmcnt(0)" ::: "memory");
    __syncthreads();
    if (threadIdx.x == 0) {
        unsigned* bar = b.bar;
        __builtin_amdgcn_s_waitcnt(0);
        unsigned nloc = b.st[0], nx = b.st[1];
        if (nloc == 0u) { xcd_barrier_complete(bar, b.x, nloc, nx); b.st[0] = nloc; b.st[1] = nx; }
        const unsigned old = xb_add(&bar[XB_XSUB(b.x)], 1u);
        const unsigned gen = old / nloc;
        if (old + 1u == (gen + 1u) * nloc) {
            __builtin_amdgcn_fence(__ATOMIC_RELEASE, "agent");
            asm volatile("s_waitcnt vmcnt(0)" ::: "memory");
            const unsigned og = xb_add(&bar[XB_TOP], 1u);
            const unsigned tg = og / nx;
            if (og + 1u == (tg + 1u) * nx) xb_add(&bar[XB_TOPGEN], 1u);
            else XB_SPIN(xb_ld(&bar[XB_TOPGEN]) == tg, bar);
            __builtin_amdgcn_fence(__ATOMIC_ACQUIRE, "agent");
            xb_add(&bar[XB_XGEN(b.x)], 1u);
            asm volatile("s_waitcnt vmcnt(0)" ::: "memory");
        } else {
            XB_SPIN(xb_ld(&bar[XB_XGEN(b.x)]) == gen, bar);
            __builtin_amdgcn_fence(__ATOMIC_ACQUIRE, "agent");
            asm volatile("s_waitcnt vmcnt(0)" ::: "memory");
        }
    }
    __syncthreads();
}

__global__ __launch_bounds__(512, 2) void mega(Params p) {
    extern __shared__ __attribute__((aligned(16))) unsigned char smem[];
    cg::grid_group grid = cg::this_grid();
    unsigned char* ws = p.ws;
    LAS unsigned char* lds = (LAS unsigned char*)smem;
    float* modp = (float*)(ws + OFF_MOD);
    float* xc = (float*)(ws + OFF_XC);
    bf16_t* H = (bf16_t*)(ws + OFF_H);
    bf16_t* Z = (bf16_t*)(ws + OFF_Z);
    const float* x_in = p.in[0]; const float* ctx_in = p.in[2];
    volatile LAS unsigned* bst = (volatile LAS unsigned*)(LAS unsigned char*)(lds + LDS_MAIN);
    XcdBarrier xb; xb.bar = (unsigned*)(ws + OFF_BAR); xb.x = 0; xb.st = bst;
    if (p.ph_hi - p.ph_lo > 1) { if (threadIdx.x < 2) bst[threadIdx.x] = 0u; __syncthreads(); xb = xcd_barrier_post((unsigned*)(ws + OFF_BAR), bst); }
    if (p.ph_hi < 0) grid.sync();
#define PHASE(ph, ...) if (p.ph_lo <= (ph) && (ph) < p.ph_hi) { __VA_ARGS__; if ((ph) + 1 < p.ph_hi) xcd_barrier(xb); }
    PHASE(0, phase_prep(p, smem))
    PHASE(1, phase_norm<false>(x_in, ctx_in, p.in[6], modp + 0 * 1024, modp + 1 * 1024, H, nullptr, MT))
    PHASE(2, { pg8::EpiBf16<0> E{Z, EVEN_IN, EVEN_IN}; pg8::gemm_phase(lds, H, 1024, (const bf16_t*)(ws + OFF_WT_IN0), MT, EVEN_PAD, 1024, E); })
    PHASE(3, phase_conv(p))
    PHASE(4, phase_scan0(p, smem))
    PHASE(5, phase_finish0(p))
    PHASE(6, { pg8::EpiResid E{x_in, ctx_in, p.out, xc, modp + 2 * 1024}; pg8::gemm_phase(lds, Z + C0_MIX, EVEN_IN, (const bf16_t*)(ws + OFF_WT_OUT0), MT, 1024, 2048, E); })
    PHASE(7, phase_norm<false>(p.out, xc, p.in[7], modp + 3 * 1024, modp + 4 * 1024, H, nullptr, MT))
    PHASE(8, { pg8::EpiBf16<1> E{Z, 4096, 4096}; pg8::gemm_phase(lds, H, 1024, (const bf16_t*)(ws + OFF_WT_W1_0), MT, 4096, 1024, E); })
    PHASE(9, { pg8::EpiResid E{p.out, xc, p.out, xc, modp + 5 * 1024}; pg8::gemm_phase(lds, Z, 4096, (const bf16_t*)(ws + OFF_WT_W2_0), MT, 1024, 4096, E); })
    PHASE(10, phase_norm<false>(p.out, xc, p.in[6] + 1024, modp + 9 * 6144 + 0 * 1024, modp + 9 * 6144 + 1 * 1024, H, nullptr, MT))
    PHASE(11, { pg8::EpiBf16<2> E{Z, ODD_IN, ODD_IN}; pg8::gemm_phase(lds, H, 1024, (const bf16_t*)(ws + OFF_WT_IN1), MT, ODD_PAD, 1024, E); })
    PHASE(12, phase_scan1(p, smem))
    PHASE(13, phase_finish1(p))
    PHASE(14, { pg8::EpiGlu E{(const bf16_t*)(ws + OFF_YS5), Z, p.in[31]}; pg8::gemm_phase(lds, (const bf16_t*)(ws + OFF_YS5), 384, (const bf16_t*)(ws + OFF_WT_GLU), ML, 512, 384, E); })
    PHASE(15, { pg8::EpiResid E{p.out, xc, p.out, xc, modp + 9 * 6144 + 2 * 1024}; pg8::gemm_phase(lds, Z, ODD_IN, (const bf16_t*)(ws + OFF_WT_OUT1), ML, 1024, 1408, E); })
    PHASE(16, phase_norm<false>(p.out, xc, p.in[7] + 1024, modp + 9 * 6144 + 3 * 1024, modp + 9 * 6144 + 4 * 1024, H, nullptr, ML))
    PHASE(17, { pg8::EpiBf16<1> E{Z, 4096, 4096}; pg8::gemm_phase(lds, H, 1024, (const bf16_t*)(ws + OFF_WT_W1_1), ML, 4096, 1024, E); })
    PHASE(18, { pg8::EpiResid E{p.out, xc, p.out, xc, modp + 9 * 6144 + 5 * 1024}; pg8::gemm_phase(lds, Z, 4096, (const bf16_t*)(ws + OFF_WT_W2_1), ML, 1024, 4096, E); })
    PHASE(19, phase_norm<true>(p.out, xc, p.in[35], nullptr, nullptr, nullptr, p.out, ML))
#undef PHASE
}

extern "C" void kernel_launch(void* const* d_in, const int* in_sizes, int n_in, void* d_out, int out_size, void* d_ws, size_t ws_size, hipStream_t stream) {
    static int grid = 0;
    if (grid == 0) {
        if (n_in != 36 || out_size != ML * DM || ws_size < WS_TOTAL) { fprintf(stderr, "kernel_launch: unexpected shapes: n_in %d out %d ws %zu (need %zu)\n", n_in, out_size, ws_size, (size_t)WS_TOTAL); grid = -1; return; }
        int dev = 0, cus = 0, per_cu = 0;
        hipGetDevice(&dev); hipDeviceGetAttribute(&cus, hipDeviceAttributeMultiprocessorCount, dev);
        if (hipFuncSetAttribute((const void*)mega, hipFuncAttributeMaxDynamicSharedMemorySize, LDS_BYTES) != hipSuccess) { fprintf(stderr, "kernel_launch: hipFuncSetAttribute failed\n"); grid = -1; return; }
        hipOccupancyMaxActiveBlocksPerMultiprocessor(&per_cu, (const void*)mega, 512, LDS_BYTES);
        if (per_cu < 1) fprintf(stderr, "kernel_launch: occupancy query says %d blocks per CU\n", per_cu);
        (void)hipGetLastError();
        grid = cus > 0 ? cus : 256;
    }
    if (grid < 0) return;
    Params p{};
    for (int i = 0; i < 36; ++i) p.in[i] = (const float*)d_in[i];
    p.out = (float*)d_out; p.ws = (unsigned char*)d_ws;
#if MK_MODE == 0
    if (hipMemsetAsync((unsigned char*)d_ws + OFF_BAR, 0, 3456 * 4, stream) != hipSuccess) { fprintf(stderr, "kernel_launch: memset of the barrier words failed\n"); return; }
    p.ph_lo = 0; p.ph_hi = NPH;
    void* args[] = {&p};
    hipError_t e = hipLaunchCooperativeKernel((const void*)mega, dim3(grid), dim3(512), args, LDS_BYTES, stream);
    if (e != hipSuccess) fprintf(stderr, "cooperative launch failed: %s (grid %d)\n", hipGetErrorString(e), grid);
#else
    for (int ph = 0; ph < NPH; ++ph) { p.ph_lo = ph; p.ph_hi = ph + 1; hipLaunchKernelGGL(mega, dim3(grid), dim3(512), LDS_BYTES, stream, p); }
#endif
}
```

```cpp
#include <hip/hip_runtime.h>
#include <hip/hip_cooperative_groups.h>
#include <cstdio>
#include <cstdint>
namespace cg = cooperative_groups;

#ifndef MK_MODE
#define MK_MODE 0
#endif

#define LAS __attribute__((address_space(3)))
typedef unsigned short bf16_t;
typedef short bf16x8 __attribute__((ext_vector_type(8)));
typedef float f32x4 __attribute__((ext_vector_type(4)));
typedef float f32x2 __attribute__((ext_vector_type(2)));
typedef unsigned u32x4 __attribute__((ext_vector_type(4)));
typedef unsigned u32x2 __attribute__((ext_vector_type(2)));

constexpr int DM = 1024, NB = 8, TL = 8192, TC = 256;
constexpr int ML = NB * TL;
constexpr int MC = NB * TC;
constexpr int MT = ML + MC;
constexpr int CH = 32;
constexpr int NCH = (TC + TL) / CH;
constexpr int NCH_C = TC / CH;
constexpr int EVEN_IN = 6208, EVEN_PAD = 6400, ODD_IN = 5504, ODD_PAD = 5632;
constexpr float EPS = 1e-6f;
constexpr int C0_Z = 0, C0_XBC = 1024, C0_DT = 3072, C0_Q = 3104, C0_K = 3616, C0_V = 4128, C0_LR = 5152, C0_R = 5184;
constexpr int C0_Y = 1024, C0_O = 2048, C0_MIX = 3104;
constexpr int C1_Q = 0, C1_I = 1024, C1_F = 2048, C1_G = 4096, C1_U = 5120;

constexpr size_t OFF_WT_IN0 = 0;
constexpr size_t OFF_WT_OUT0 = OFF_WT_IN0 + (size_t)EVEN_PAD * 1024 * 2;
constexpr size_t OFF_WT_W1_0 = OFF_WT_OUT0 + 1024ull * 2048 * 2;
constexpr size_t OFF_WT_W2_0 = OFF_WT_W1_0 + 4096ull * 1024 * 2;
constexpr size_t OFF_WT_IN1 = OFF_WT_W2_0 + 4096ull * 1024 * 2;
constexpr size_t OFF_WT_OUT1 = OFF_WT_IN1 + (size_t)ODD_PAD * 1024 * 2;
constexpr size_t OFF_WT_W1_1 = OFF_WT_OUT1 + 1024ull * 1408 * 2;
constexpr size_t OFF_WT_W2_1 = OFF_WT_W1_1 + 4096ull * 1024 * 2;
constexpr size_t OFF_WT_GLU = OFF_WT_W2_1 + 4096ull * 1024 * 2;
constexpr size_t OFF_MOD = OFF_WT_GLU + 512ull * 384 * 2;
constexpr size_t OFF_XC = OFF_MOD + 2ull * 9 * 6144 * 4;
constexpr size_t OFF_H = OFF_XC + 2048ull * 1024 * 4;
constexpr size_t OFF_Z = OFF_H + (size_t)MT * 1024 * 2;
constexpr size_t WS_END = OFF_Z + (size_t)MT * EVEN_IN * 2;
constexpr size_t OFF_YS5 = OFF_Z + (size_t)MT * ODD_IN * 2;
constexpr size_t OFF_BAR = WS_END;
constexpr size_t WS_TOTAL = OFF_BAR + 3456 * 4;
static_assert(WS_TOTAL <= (1ull << 30), "workspace");
static_assert(OFF_YS5 + (size_t)ML * 384 * 2 <= WS_END, "ys5");
static_assert(OFF_MOD % 256 == 0 && OFF_XC % 256 == 0 && OFF_H % 256 == 0 && OFF_Z % 256 == 0 && OFF_YS5 % 16 == 0, "align");

constexpr int LDS_MAIN = 131072;
constexpr int LDS_BYTES = LDS_MAIN + 16;
constexpr int NPH = 20;

struct Params { const float* in[36]; float* out; unsigned char* ws; int ph_lo, ph_hi; };

typedef __bf16 bf16x2v __attribute__((ext_vector_type(2)));
__device__ __forceinline__ unsigned cvt_pk_bf16(float lo, float hi) { const f32x2 v = {lo, hi}; return __builtin_bit_cast(unsigned, __builtin_convertvector(v, bf16x2v)); }
__device__ __forceinline__ float bf2f(bf16_t u) { return __uint_as_float(((unsigned)u) << 16); }
__device__ __forceinline__ bf16_t f2bf(float f) { return (bf16_t)(cvt_pk_bf16(f, 0.f) & 0xffffu); }
__device__ __forceinline__ void unpack2(unsigned v, float& a, float& b) { a = __uint_as_float(v << 16); b = __uint_as_float(v & 0xffff0000u); }
__device__ __forceinline__ void unpack8(u32x4 v, float* f) { unpack2(v.x, f[0], f[1]); unpack2(v.y, f[2], f[3]); unpack2(v.z, f[4], f[5]); unpack2(v.w, f[6], f[7]); }
__device__ __forceinline__ u32x4 pack8(const float* f) { u32x4 r; r.x = cvt_pk_bf16(f[0], f[1]); r.y = cvt_pk_bf16(f[2], f[3]); r.z = cvt_pk_bf16(f[4], f[5]); r.w = cvt_pk_bf16(f[6], f[7]); return r; }
__device__ __forceinline__ float exp2f_(float x) { return __builtin_amdgcn_exp2f(x); }
__device__ __forceinline__ float sigmoidf_(float x) { return __builtin_amdgcn_rcpf(1.f + __expf(-x)); }
__device__ __forceinline__ float siluf_(float x) { return x * __builtin_amdgcn_rcpf(1.f + __expf(-x)); }
__device__ __forceinline__ float softplusf_(float x) { return x > 20.f ? x : log1pf(expf(x)); }
__device__ __forceinline__ float logsigmoidf_(float x) { return fminf(x, 0.f) - log1pf(expf(-fabsf(x))); }
__device__ __forceinline__ float gelu_tanh(float x) { const float u = 0.7978845608028654f * (x + 0.044715f * x * x * x); return 0.5f * x * (1.f + tanhf(u)); }
__device__ __forceinline__ float wave_sum(float v) {
#pragma unroll
    for (int o = 1; o < 64; o <<= 1) v += __shfl_xor(v, o);
    return v;
}
__device__ __forceinline__ int mod_idx(int r) { return r < ML ? (r >> 13) : 8; }
__device__ __forceinline__ int row_of(int b, int d, int s) {
    if (s < TC) { const int t = d ? (TC - 1 - s) : s; return ML + b * TC + t; }
    int t = s - TC; if (d) t = TL - 1 - t; return b * TL + t;
}
__device__ __forceinline__ bool first_arrival(int ci) { return ci < NCH_C ? (ci < NCH_C / 2) : ((ci - NCH_C) < (NCH - NCH_C) / 2); }

namespace pg8 {
constexpr int BM = 256, BK = 64, HALF = 128, HTB = HALF * BK * 2, STAGE_BYTES = 8 * HTB, NXCD = 8, WGM = 4;
__device__ __forceinline__ int lds_byte(int r, int c) { const int st = (r >> 4) * 2 + (c >> 5), rr = r & 15, cc = c & 31, ob = rr * 64 + cc * 2; return st * 1024 + (ob ^ (((ob >> 9) & 1) << 5)); }
__device__ __forceinline__ void stage_rc(int b, int& R, int& C) { const int st = b / 1024, sb = b % 1024, swz = sb ^ (((sb >> 9) & 1) << 5); R = (st >> 1) * 16 + swz / 64; C = (st & 1) * 32 + (swz % 64) / 2; }
__device__ __forceinline__ int perm32(int rho) { const int n = rho >> 4, i = rho & 15; return 8 * (i >> 2) + 4 * n + (i & 3); }
struct Unit { int pm, pn; };
struct StaticOrder {
    int nM, nN, nwg, G, c;
    __device__ void init(int M, int N, int G_, int c_) { nM = M / BM; nN = N / BM; nwg = nM * nN; G = G_; c = c_; }
    __device__ bool next(int i, Unit& u) const {
        const long L = (long)i * G + c; if (L >= nwg) return false;
        int wgid = (int)L; { const int q = nwg / NXCD, r = nwg % NXCD, xcd = wgid % NXCD, off = wgid / NXCD; wgid = (xcd < r ? xcd * (q + 1) : r * (q + 1) + (xcd - r) * q) + off; }
        const int nig = WGM * nN, gid = wgid / nig, fm = gid * WGM, gsz = (nM - fm) < WGM ? (nM - fm) : WGM;
        u.pm = fm + ((wgid % nig) % gsz); u.pn = (wgid % nig) / gsz; return true;
    }
};
template <class Epi>
__device__ __forceinline__ void gemm_phase(LAS unsigned char* lds, const bf16_t* A, int lda, const bf16_t* Bt, int M, int N, int K, const Epi& E) {
    StaticOrder S; S.init(M, N, (int)gridDim.x, (int)blockIdx.x);
    const int tid = threadIdx.x, wid = __builtin_amdgcn_readfirstlane(tid >> 6), lane = tid & 63, wr = wid >> 2, wc = wid & 3, fr = lane & 15, fq = lane >> 4;
    const int nt = K / BK;
    unsigned voffA[2], voffB[2];
#pragma unroll
    for (int i = 0; i < 2; ++i) { int R, C; stage_rc(tid * 16 + i * 8192, R, C); const int Rb = Epi::PERM ? ((R & ~31) + perm32(R & 31)) : R;
        voffA[i] = (unsigned)(R * lda + C) * 2u; voffB[i] = (unsigned)(Rb * K + C) * 2u; }
    const size_t kstep = (size_t)(BK * 2);
    const size_t hstepA = (size_t)HALF * lda * 2, hstepB = (size_t)HALF * K * 2;
    const size_t tstepA = 2 * hstepA, tstepB = 2 * hstepB;
    const unsigned ldsw = (unsigned)wid * 1024u;
    const int aoff = lds_byte(wr * 64 + fr, fq * 8), boff = lds_byte(wc * 32 + fr, fq * 8);
#define PG8_SA(b, h) (((b) * 2 + (h)) * HTB)
#define PG8_SB(b, h) ((4 + (b) * 2 + (h)) * HTB)
#define PG8_STAGE(bufoff, gbase, voff) do { _Pragma("unroll") for (int _i = 0; _i < 2; ++_i) \
        __builtin_amdgcn_global_load_lds((const unsigned*)((const char*)(gbase) + (voff)[_i]), (LAS unsigned*)(lds + (bufoff) + ldsw + _i * 8192), 16, 0, 0); } while (0)
#define PG8_LDA(dst, b, h) do { _Pragma("unroll") for (int m = 0; m < 4; ++m) _Pragma("unroll") for (int k = 0; k < 2; ++k) dst[m][k] = *(const LAS bf16x8*)(lds + PG8_SA(b, h) + aoff + m * 2048 + k * 1024); } while (0)
#define PG8_LDB(dst, b, h) do { _Pragma("unroll") for (int n = 0; n < 2; ++n) _Pragma("unroll") for (int k = 0; k < 2; ++k) dst[n][k] = *(const LAS bf16x8*)(lds + PG8_SB(b, h) + boff + n * 2048 + k * 1024); } while (0)
#define PG8_MMA(ai, bj, At, Bt_) do { __builtin_amdgcn_s_setprio(1); _Pragma("unroll") for (int m = 0; m < 4; ++m) _Pragma("unroll") for (int n = 0; n < 2; ++n) _Pragma("unroll") for (int k = 0; k < 2; ++k) \
        acc[ai][bj][m][n] = __builtin_amdgcn_mfma_f32_16x16x32_bf16(Bt_[n][k], At[m][k], acc[ai][bj][m][n], 0, 0, 0); __builtin_amdgcn_s_setprio(0); } while (0)
#define PG8_WAIT_V(n) asm volatile("s_waitcnt vmcnt(" #n ")" ::: "memory")
#define PG8_WAIT_L(n) asm volatile("s_waitcnt lgkmcnt(" #n ")" ::: "memory")
#define PG8_BAR __builtin_amdgcn_s_barrier()
#define PG8_SCHED __builtin_amdgcn_sched_barrier(0)
    Unit cur, nxt; int ui = 0;
    if (!S.next(0, cur)) return;
    f32x4 acc[2][2][4][2];
#pragma unroll
    for (int a = 0; a < 2; ++a)
#pragma unroll
        for (int b = 0; b < 2; ++b)
#pragma unroll
            for (int m = 0; m < 4; ++m)
#pragma unroll
                for (int n = 0; n < 2; ++n) acc[a][b][m][n] = (f32x4){0.f, 0.f, 0.f, 0.f};
    bf16x8 At[4][2], B0[2][2], B1[2][2];
    const char* cA = (const char*)A + (size_t)cur.pm * tstepA; const char* cB = (const char*)Bt + (size_t)cur.pn * tstepB;
    PG8_STAGE(PG8_SB(0, 0), cB, voffB); PG8_STAGE(PG8_SA(0, 0), cA, voffA); PG8_STAGE(PG8_SB(0, 1), cB + hstepB, voffB); PG8_STAGE(PG8_SA(0, 1), cA + hstepA, voffA);
    if (wr == 1) PG8_BAR;
    PG8_WAIT_V(4); PG8_BAR;
    PG8_STAGE(PG8_SB(1, 0), cB + kstep, voffB); PG8_STAGE(PG8_SA(1, 0), cA + kstep, voffA); PG8_STAGE(PG8_SB(1, 1), cB + hstepB + kstep, voffB);
    PG8_WAIT_V(6); PG8_BAR;
    for (;;) {
        const bool has_next = S.next(ui + 1, nxt);
        const char* nA = has_next ? (const char*)A + (size_t)nxt.pm * tstepA : cA; const char* nB = has_next ? (const char*)Bt + (size_t)nxt.pn * tstepB : cB;
#pragma nounroll
        for (int t = 0; t < nt; t += 2) {
            const bool last = (t == nt - 2);
            const char* a1 = cA + (size_t)(t + 1) * kstep;
            const char* a2 = last ? nA : cA + (size_t)(t + 2) * kstep; const char* b2 = last ? nB : cB + (size_t)(t + 2) * kstep;
            const char* a3 = a2 + kstep; const char* b3 = b2 + kstep;
            PG8_LDB(B0, 0, 0); PG8_SCHED; PG8_LDA(At, 0, 0); PG8_STAGE(PG8_SA(1, 1), a1 + hstepA, voffA);
            PG8_WAIT_L(8); PG8_BAR; PG8_WAIT_L(0); PG8_MMA(0, 0, At, B0); PG8_BAR; PG8_SCHED;
            PG8_LDB(B1, 0, 1); PG8_STAGE(PG8_SB(0, 0), b2, voffB);
            PG8_BAR; PG8_WAIT_L(0); PG8_MMA(0, 1, At, B1); PG8_BAR;
            PG8_LDA(At, 0, 1); PG8_STAGE(PG8_SA(0, 0), a2, voffA);
            PG8_BAR; PG8_WAIT_L(0); PG8_MMA(1, 0, At, B0); PG8_BAR; PG8_SCHED;
            PG8_STAGE(PG8_SB(0, 1), b2 + hstepB, voffB);
            PG8_WAIT_V(6); PG8_BAR; PG8_MMA(1, 1, At, B1); PG8_BAR;
            PG8_LDB(B0, 1, 0); PG8_SCHED; PG8_LDA(At, 1, 0); PG8_STAGE(PG8_SA(0, 1), a2 + hstepA, voffA);
            PG8_WAIT_L(8); PG8_BAR; PG8_WAIT_L(0); PG8_MMA(0, 0, At, B0); PG8_BAR; PG8_SCHED;
            PG8_LDB(B1, 1, 1); PG8_STAGE(PG8_SB(1, 0), b3, voffB);
            PG8_BAR; PG8_WAIT_L(0); PG8_MMA(0, 1, At, B1); PG8_BAR;
            PG8_LDA(At, 1, 1); PG8_STAGE(PG8_SA(1, 0), a3, voffA);
            PG8_BAR; PG8_WAIT_L(0); PG8_MMA(1, 0, At, B0); PG8_BAR; PG8_SCHED;
            PG8_STAGE(PG8_SB(1, 1), b3 + hstepB, voffB);
            PG8_WAIT_V(6); PG8_BAR; PG8_MMA(1, 1, At, B1); PG8_BAR;
        }
        E(acc, cur, wr, wc, fr, fq);
        if (!has_next) break;
#pragma unroll
        for (int a = 0; a < 2; ++a)
#pragma unroll
            for (int b = 0; b < 2; ++b)
#pragma unroll
                for (int m = 0; m < 4; ++m)
#pragma unroll
                    for (int n = 0; n < 2; ++n) acc[a][b][m][n] = (f32x4){0.f, 0.f, 0.f, 0.f};
        cur = nxt; cA = nA; cB = nB; ++ui;
    }
    PG8_WAIT_V(0);
    if (wr == 0) PG8_BAR;
    PG8_BAR;
#undef PG8_SA
#undef PG8_SB
#undef PG8_STAGE
#undef PG8_LDA
#undef PG8_LDB
#undef PG8_MMA
#undef PG8_WAIT_V
#undef PG8_WAIT_L
#undef PG8_BAR
#undef PG8_SCHED
}

template <int ACT  > struct EpiBf16 {
    static constexpr bool PERM = true;
    bf16_t* O; int ldc; int nvalid;
    __device__ __forceinline__ void operator()(const f32x4 (&acc)[2][2][4][2], const Unit& u, int wr, int wc, int fr, int fq) const {
        const int row0 = u.pm * BM + wr * 64 + fr, col0 = u.pn * BM + wc * 32 + 8 * fq;
#pragma unroll
        for (int ai = 0; ai < 2; ++ai)
#pragma unroll
            for (int m = 0; m < 4; ++m) { bf16_t* rowp = O + (size_t)(row0 + ai * HALF + m * 16) * ldc + col0;
#pragma unroll
                for (int bj = 0; bj < 2; ++bj) { if (col0 + bj * HALF < nvalid) { f32x4 v0 = acc[ai][bj][m][0], v1 = acc[ai][bj][m][1];
                    if (ACT == 1) {
#pragma unroll
                        for (int j = 0; j < 4; ++j) { const float a = fmaxf(v0[j], 0.f), b = fmaxf(v1[j], 0.f); v0[j] = a * a; v1[j] = b * b; } }
                    if (ACT == 2) { if (u.pn < 4) {
#pragma unroll
                        for (int j = 0; j < 4; ++j) { v0[j] = siluf_(v0[j]); v1[j] = siluf_(v1[j]); } } }
                    u32x4 w; w.x = cvt_pk_bf16(v0[0], v0[1]); w.y = cvt_pk_bf16(v0[2], v0[3]); w.z = cvt_pk_bf16(v1[0], v1[1]); w.w = cvt_pk_bf16(v1[2], v1[3]);
                    *(u32x4*)(rowp + bj * HALF) = w; } } }
    }
};
struct EpiResid {
    static constexpr bool PERM = false;
    const float* in_lat; const float* in_ctx; float* out_lat; float* out_ctx; const float* gate;
    __device__ __forceinline__ void operator()(const f32x4 (&acc)[2][2][4][2], const Unit& u, int wr, int wc, int fr, int fq) const {
        const int row0 = u.pm * BM + wr * 64 + fr, col0 = u.pn * BM + wc * 32 + 4 * fq;
#pragma unroll
        for (int ai = 0; ai < 2; ++ai)
#pragma unroll
            for (int m = 0; m < 4; ++m) { const int r = row0 + ai * HALF + m * 16;
                const float* ip = r < ML ? in_lat + (size_t)r * DM : in_ctx + (size_t)(r - ML) * DM;
                float* op = r < ML ? out_lat + (size_t)r * DM : out_ctx + (size_t)(r - ML) * DM;
                const float* gp = gate + mod_idx(r) * 6144;
#pragma unroll
                for (int bj = 0; bj < 2; ++bj)
#pragma unroll
                    for (int n = 0; n < 2; ++n) { const int c = col0 + bj * HALF + n * 16;
                        const f32x4 g = *(const f32x4*)(gp + c), x = *(const f32x4*)(ip + c);
                        *(f32x4*)(op + c) = x + g * acc[ai][bj][m][n]; } }
    }
};
struct EpiGlu {
    static constexpr bool PERM = true;
    const bf16_t* YG; bf16_t* Z1; const float* bias;
    __device__ __forceinline__ void operator()(const f32x4 (&acc)[2][2][4][2], const Unit& u, int wr, int wc, int fr, int fq) const {
        const int row0 = u.pm * BM + wr * 64 + fr, col0 = u.pn * BM + wc * 32 + 8 * fq;
#pragma unroll
        for (int ai = 0; ai < 2; ++ai)
#pragma unroll
            for (int m = 0; m < 4; ++m) { const int r = row0 + ai * HALF + m * 16;
#pragma unroll
                for (int bj = 0; bj < 2; ++bj) { const int c = col0 + bj * HALF; if (c < 384) {
#pragma unroll
                    for (int n = 0; n < 2; ++n) {
                        const u32x2 yv = *(const u32x2*)(YG + (size_t)r * 384 + c + 4 * n); float y0, y1, y2, y3; unpack2(yv.x, y0, y1); unpack2(yv.y, y2, y3);
                        const f32x4 b0 = *(const f32x4*)(bias + c + 4 * n); const f32x4 a = acc[ai][bj][m][n];
                        u32x2 w; w.x = cvt_pk_bf16(y0 * sigmoidf_(a[0] + b0[0]), y1 * sigmoidf_(a[1] + b0[1])); w.y = cvt_pk_bf16(y2 * sigmoidf_(a[2] + b0[2]), y3 * sigmoidf_(a[3] + b0[3]));
                        *(u32x2*)(Z1 + (size_t)r * ODD_IN + 1024 + c + 4 * n) = w; } } } }
    }
};
}

__device__ __forceinline__ void transpose_job(const float* W, int K, int N, bf16_t* WT, float* scr, int gw, int ngw, int lane) {
    const int nblk = N / 32, nitems = (K / 64) * nblk;
    for (int item = gw; item < nitems; item += ngw) {
        const int kb = item / nblk, nb = item % nblk, k0 = 64 * kb, n0 = 32 * nb;
#pragma unroll 8
        for (int i = 0; i < 32; ++i) { const int kk = 2 * i + (lane >> 5); scr[kk * 33 + (lane & 31)] = W[(size_t)(k0 + kk) * N + n0 + (lane & 31)]; }
        __builtin_amdgcn_wave_barrier(); asm volatile("s_waitcnt lgkmcnt(0)" ::: "memory");
        const int c = lane & 7;
#pragma unroll
        for (int j = 0; j < 4; ++j) { const int n = (lane >> 3) + 8 * j; const float* s = scr + (8 * c) * 33 + n;
            u32x4 o; o.x = cvt_pk_bf16(s[0 * 33], s[1 * 33]); o.y = cvt_pk_bf16(s[2 * 33], s[3 * 33]); o.z = cvt_pk_bf16(s[4 * 33], s[5 * 33]); o.w = cvt_pk_bf16(s[6 * 33], s[7 * 33]);
            *(u32x4*)(WT + (size_t)(n0 + n) * K + k0 + 8 * c) = o; }
        __builtin_amdgcn_wave_barrier(); asm volatile("s_waitcnt lgkmcnt(0)" ::: "memory");
    }
}
__device__ __forceinline__ void zero_rows(bf16_t* p, size_t nelem, int blk, int nblk) {
    const size_t n16 = nelem / 8; u32x4* q = (u32x4*)p;
    for (size_t i = (size_t)blk * 512 + threadIdx.x; i < n16; i += (size_t)nblk * 512) q[i] = (u32x4){0u, 0u, 0u, 0u};
}
__device__ __forceinline__ void phase_prep(const Params& p, unsigned char* smem) {
    const int tid = threadIdx.x, lane = tid & 63, wave = tid >> 6;
    const int gw = blockIdx.x * 8 + wave, ngw = gridDim.x * 8;
    float* scr = (float*)smem + wave * (64 * 33);
    unsigned char* ws = p.ws;
    transpose_job(p.in[8], 1024, EVEN_IN, (bf16_t*)(ws + OFF_WT_IN0), scr, gw, ngw, lane);
    zero_rows((bf16_t*)(ws + OFF_WT_IN0) + (size_t)EVEN_IN * 1024, (size_t)(EVEN_PAD - EVEN_IN) * 1024, blockIdx.x, gridDim.x);
    __syncthreads();
    float* sv = (float*)smem;
    float* red = sv + 9 * 1024;
    float* modp = (float*)(ws + OFF_MOD);
    bool sv_ready = false;
    for (int u = (int)gridDim.x - 1 - (int)blockIdx.x; u < 192; u += gridDim.x) {
        if (!sv_ready) { for (int i = tid; i < 9 * 1024; i += 512) { const float cv = i < 8192 ? p.in[1][i] : p.in[3][i - 8192]; sv[i] = siluf_(cv); } sv_ready = true; }
        __syncthreads();
        const int layer = u / 96, c0 = (u % 96) * 64, kg = tid >> 6, col = tid & 63;
        float acc[9];
#pragma unroll
        for (int i = 0; i < 9; ++i) acc[i] = 0.f;
        const float* wp = p.in[4] + ((size_t)layer * 1024 + kg * 128) * 6144 + c0 + col;
#pragma unroll 4
        for (int kk = 0; kk < 128; ++kk) { const float w = wp[(size_t)kk * 6144];
#pragma unroll
            for (int i = 0; i < 9; ++i) acc[i] = fmaf(sv[i * 1024 + kg * 128 + kk], w, acc[i]); }
#pragma unroll
        for (int i = 0; i < 9; ++i) red[(kg * 9 + i) * 64 + col] = acc[i];
        __syncthreads();
        for (int o = tid; o < 9 * 64; o += 512) { const int i = o >> 6, cc = o & 63; float s = p.in[5][layer * 6144 + c0 + cc];
#pragma unroll
            for (int k2 = 0; k2 < 8; ++k2) s += red[(k2 * 9 + i) * 64 + cc];
            modp[((size_t)layer * 9 + i) * 6144 + c0 + cc] = s; }
        __syncthreads();
    }
}

template <bool FINAL>
__device__ __forceinline__ void phase_norm(const float* src_lat, const float* src_ctx, const float* nw, const float* mod_sh, const float* mod_sc, bf16_t* H, float* outf, int nrows) {
    const int lane = threadIdx.x & 63, gw = blockIdx.x * 8 + (threadIdx.x >> 6), ngw = gridDim.x * 8;
    constexpr int RW = 4;
    for (int r0 = gw * RW; r0 < nrows; r0 += ngw * RW) {
        f32x4 v[RW][4]; float ss[RW];
#pragma unroll
        for (int q = 0; q < RW; ++q) { const int r = r0 + q; const float* src = r < ML ? src_lat + (size_t)r * DM : src_ctx + (size_t)(r - ML) * DM;
#pragma unroll
            for (int j = 0; j < 4; ++j) v[q][j] = *(const f32x4*)(src + lane * 4 + 256 * j); }
#pragma unroll
        for (int q = 0; q < RW; ++q) { float s_ = 0.f;
#pragma unroll
            for (int j = 0; j < 4; ++j) s_ += v[q][j].x * v[q][j].x + v[q][j].y * v[q][j].y + v[q][j].z * v[q][j].z + v[q][j].w * v[q][j].w;
            ss[q] = s_; }
#pragma unroll
        for (int o = 1; o < 64; o <<= 1) {
#pragma unroll
            for (int q = 0; q < RW; ++q) ss[q] += __shfl_xor(ss[q], o); }
#pragma unroll
        for (int q = 0; q < RW; ++q) { const int r = r0 + q; const float rstd = rsqrtf(ss[q] * (1.f / DM) + EPS); const int mi = mod_idx(r);
#pragma unroll
            for (int j = 0; j < 4; ++j) { const int c = lane * 4 + 256 * j; const f32x4 w4 = *(const f32x4*)(nw + c); f32x4 y = v[q][j] * rstd * w4;
                if (FINAL) { *(f32x4*)(outf + (size_t)r * DM + c) = y; }
                else { const f32x4 sc = *(const f32x4*)(mod_sc + mi * 6144 + c), sh = *(const f32x4*)(mod_sh + mi * 6144 + c); y = y * (1.f + sc) + sh;
                    u32x2 o; o.x = cvt_pk_bf16(y.x, y.y); o.y = cvt_pk_bf16(y.z, y.w); *(u32x2*)(H + (size_t)r * DM + c) = o; } } }
    }
}

__device__ __forceinline__ void phase_conv(const Params& p) {
    const int tid = threadIdx.x, cgp = tid & 255, sub = tid >> 8, ch = cgp * 8;
    const bf16_t* Z = (const bf16_t*)(p.ws + OFF_Z);
    bf16_t* xl = (bf16_t*)p.out; bf16_t* xc = (bf16_t*)(p.ws + OFF_H);
    const float* cw = p.in[9]; const float* cb = p.in[10];
    float w[9][8], bias[8];
#pragma unroll
    for (int k = 0; k < 9; ++k)
#pragma unroll
        for (int i = 0; i < 8; ++i) w[k][i] = cw[k * 2048 + ch + i];
#pragma unroll
    for (int i = 0; i < 8; ++i) bias[i] = cb[ch + i];
    for (int q = blockIdx.x * 2 + sub; q < MT / 4; q += gridDim.x * 2) {
        const int r0 = q * 4;
        float acc[4][8];
#pragma unroll
        for (int o = 0; o < 4; ++o)
#pragma unroll
            for (int i = 0; i < 8; ++i) acc[o][i] = bias[i];
        const bool lat = r0 < ML;
        const int t0 = lat ? (r0 & (TL - 1)) : ((r0 - ML) & (TC - 1)), gy = t0 >> 6, gx0 = lat ? (t0 & 63) : t0, W = lat ? 64 : TC;
#pragma unroll
        for (int dy = -1; dy <= 1; ++dy) {
            if (dy != 0 && (!lat || gy + dy < 0 || gy + dy >= TL / 64)) continue;
            u32x4 v[6];
#pragma unroll
            for (int c = 0; c < 6; ++c) { const int gx = gx0 - 1 + c; v[c] = (gx >= 0 && gx < W) ? *(const u32x4*)(Z + (size_t)(r0 + dy * 64 - 1 + c) * EVEN_IN + C0_XBC + ch) : (u32x4){0u, 0u, 0u, 0u}; }
#pragma unroll
            for (int c = 0; c < 6; ++c) { float f[8]; unpack8(v[c], f);
#pragma unroll
                for (int o = 0; o < 4; ++o) { const int dx = c - 1 - o;
                    if (dx >= -1 && dx <= 1) {
#pragma unroll
                        for (int i = 0; i < 8; ++i) acc[o][i] = fmaf(f[i], w[(dy + 1) * 3 + dx + 1][i], acc[o][i]); } } }
        }
#pragma unroll
        for (int o = 0; o < 4; ++o) { const int r = r0 + o;
#pragma unroll
            for (int i = 0; i < 8; ++i) acc[o][i] = siluf_(acc[o][i]);
            bf16_t* dst = lat ? xl + (size_t)r * 2048 + ch : xc + (size_t)(r - ML) * 2048 + ch;
            *(u32x4*)dst = pack8(acc[o]); }
    }
}

__device__ __forceinline__ void lds_barrier() { asm volatile("s_waitcnt lgkmcnt(0)\n\ts_barrier" ::: "memory"); }
typedef short s16x4 __attribute__((ext_vector_type(4)));
__device__ __forceinline__ bf16x8 tr2(const bf16_t* p0, const bf16_t* p1) {
    const s16x4 a = __builtin_amdgcn_ds_read_tr16_b64_v4i16((LAS s16x4*)p0), b = __builtin_amdgcn_ds_read_tr16_b64_v4i16((LAS s16x4*)p1);
    return __builtin_shufflevector(a, b, 0, 1, 2, 3, 4, 5, 6, 7);
}
template <int MIX> struct MixCfg;
template <> struct MixCfg<0> { static constexpr int DK = 128, DV = 64; static constexpr bool SC = true; };
template <> struct MixCfg<1> { static constexpr int DK = 64, DV = 128; static constexpr bool SC = false; };
template <> struct MixCfg<2> { static constexpr int DK = 128, DV = 128; static constexpr bool SC = false; };
__device__ __forceinline__ bf16x8 tr_read8(unsigned a0, unsigned a1) {
    u32x2 lo, hi;
    asm volatile("ds_read_b64_tr_b16 %0, %2\n\tds_read_b64_tr_b16 %1, %3\n\ts_waitcnt lgkmcnt(0)" : "=&v"(lo), "=&v"(hi) : "v"(a0), "v"(a1) : "memory");
    u32x4 r; r.x = lo.x; r.y = lo.y; r.z = hi.x; r.w = hi.y; return __builtin_bit_cast(bf16x8, r);
}
template <int O0, int O1, int O2, int O3>
__device__ __forceinline__ void tr_read_x4(unsigned base, u32x2& d0, u32x2& d1, u32x2& d2, u32x2& d3) {
    asm volatile("ds_read_b64_tr_b16 %0, %4 offset:%5\n\tds_read_b64_tr_b16 %1, %4 offset:%6\n\tds_read_b64_tr_b16 %2, %4 offset:%7\n\tds_read_b64_tr_b16 %3, %4 offset:%8\n\ts_waitcnt lgkmcnt(0)"
                 : "=&v"(d0), "=&v"(d1), "=&v"(d2), "=&v"(d3) : "v"(base), "i"(O0), "i"(O1), "i"(O2), "i"(O3) : "memory");
}
template <int O0, int O1, int O2, int O3, int O4, int O5, int O6, int O7>
__device__ __forceinline__ void tr_read_x8(unsigned base, u32x2& d0, u32x2& d1, u32x2& d2, u32x2& d3, u32x2& d4, u32x2& d5, u32x2& d6, u32x2& d7) {
    asm volatile("ds_read_b64_tr_b16 %0, %8 offset:%9\n\tds_read_b64_tr_b16 %1, %8 offset:%10\n\tds_read_b64_tr_b16 %2, %8 offset:%11\n\tds_read_b64_tr_b16 %3, %8 offset:%12\n\t"
                 "ds_read_b64_tr_b16 %4, %8 offset:%13\n\tds_read_b64_tr_b16 %5, %8 offset:%14\n\tds_read_b64_tr_b16 %6, %8 offset:%15\n\tds_read_b64_tr_b16 %7, %8 offset:%16\n\ts_waitcnt lgkmcnt(0)"
                 : "=&v"(d0), "=&v"(d1), "=&v"(d2), "=&v"(d3), "=&v"(d4), "=&v"(d5), "=&v"(d6), "=&v"(d7)
                 : "v"(base), "i"(O0), "i"(O1), "i"(O2), "i"(O3), "i"(O4), "i"(O5), "i"(O6), "i"(O7) : "memory");
}
__device__ __forceinline__ bf16x8 mk8(u32x2 lo, u32x2 hi) { u32x4 r; r.x = lo.x; r.y = lo.y; r.z = hi.x; r.w = hi.y; return __builtin_bit_cast(bf16x8, r); }
template <int MIX>
__device__ __forceinline__ void chunk_item(const Params& p, unsigned char* smem, int item) {
    using Cfg = MixCfg<MIX>;
    constexpr int DK = Cfg::DK, DV = Cfg::DV; constexpr bool SC = Cfg::SC;
    constexpr int QS = DK + 8, VS = DV + 8, NPT = DV / 64, NKS = DK / 32, NNS = DK / 16;
    constexpr int DIRB = (3 * 32 * QS + 32 * VS) * 2 + 32 * DK * 4 + DK * 4 + 4608;
    static_assert(2 * DIRB <= LDS_MAIN, "lds");
    const int tid = threadIdx.x, d = tid >> 8, gt = tid & 255, t_ = gt >> 3, j_ = gt & 7;
    const int w = (tid >> 6) & 3, lane = tid & 63, r16 = lane & 15, quad = lane >> 4;
    unsigned char* L = smem + d * DIRB;
    bf16_t* Qt = (bf16_t*)L; bf16_t* Kt = Qt + 32 * QS; bf16_t* Kh = Kt + 32 * QS; bf16_t* Vs = Kh + 32 * QS;
    float* Gf = (float*)(Vs + 32 * VS); float* dC = Gf + 32 * DK; float* misc = dC + DK;
    const unsigned kh_addr = (unsigned)(size_t)Kh, vs_addr = (unsigned)(size_t)Vs;
    const int b = MIX == 0 ? (item >> 4) : (item >> 3), hd = MIX == 0 ? (item & 15) : (item & 7), g = hd >> 2;
    bf16_t* Z = (bf16_t*)(p.ws + OFF_Z);
    const bf16_t* xl = (const bf16_t*)p.out; const bf16_t* xcx = (const bf16_t*)(p.ws + OFF_H);
    bf16_t* Ob = (bf16_t*)(p.ws + OFF_H);
    float dtb = 0.f, nega = 0.f, dsk = 0.f, dt_ = 0.f;
    if constexpr (MIX == 0) { dtb = p.in[11][d * 16 + hd]; nega = -expf(p.in[12][d * 16 + hd]) * 1.4426950408889634f; dsk = p.in[13][hd]; }
    __syncthreads();
    bf16x8 gwB = (bf16x8){0, 0, 0, 0, 0, 0, 0, 0}; float gbl = 0.f;
    if constexpr (MIX == 1) { float hi_[8];
#pragma unroll
        for (int j = 0; j < 8; ++j) { const float v = p.in[15][((size_t)d * 16 + (quad & 1) * 8 + j) * 512 + hd * 64 + 16 * w + r16]; const float vh = bf2f(f2bf(v)); hi_[j] = quad < 2 ? vh : v - vh; }
        const u32x4 pk = pack8(hi_); gwB = __builtin_bit_cast(bf16x8, pk); gbl = p.in[16][d * 512 + hd * 64 + 16 * w + r16]; }
    if constexpr (MIX == 2) { if (gt < 128) { const float l0 = p.in[20][d * 1024 + hd * 128 + gt], l1 = p.in[20][2048 + d * 1024 + hd * 128 + gt]; misc[gt] = 1.f / (1.f + expf(l0 - l1)); } }
    __syncthreads();
    f32x4 accS[NNS][NPT];
#pragma unroll
    for (int a = 0; a < NNS; ++a)
#pragma unroll
        for (int i = 0; i < NPT; ++i) accS[a][i] = (f32x4){0.f, 0.f, 0.f, 0.f};
    u32x4 R0, R1, R2, R3, R4, R5; bf16_t rdt = 0;
    u32x4 kst0 = (u32x4){0u, 0u, 0u, 0u}, kst1 = kst0;
    R0 = R1 = R2 = R3 = R4 = R5 = (u32x4){0u, 0u, 0u, 0u};
#define LD16(base, off) (*(const u32x4*)((const char*)(base) + (unsigned)(off)))
    const unsigned cA = MIX == 0 ? (hd * 64 + j_ * 8) * 2u : (MIX == 1 ? (C0_V + hd * 128 + j_ * 16) * 2u : (C1_I + hd * 128 + j_ * 16) * 2u);
    const unsigned cB = MIX == 0 ? (1024 + g * 128 + j_ * 16) * 2u : (MIX == 1 ? (C0_K + hd * 64 + j_ * 8) * 2u : (C1_Q + hd * 128 + j_ * 16) * 2u);
    const unsigned cC = MIX == 0 ? (1536 + g * 128 + j_ * 16) * 2u : (MIX == 1 ? (C0_Q + hd * 64 + j_ * 8) * 2u : (C1_F + d * 1024 + hd * 128 + j_ * 16) * 2u);
    const unsigned cD = MIX == 0 ? (C0_DT + d * 16 + hd) * 2u : (C0_LR + d * 16 + (quad & 1) * 8) * 2u;
#define CK_LOAD(ci) do { const int r_ = row_of(b, d, (ci) * CH + t_); \
        if constexpr (MIX == 0) { const bool lat_ = (ci) >= NCH_C; const char* xb_ = lat_ ? (const char*)xl : (const char*)xcx - (size_t)ML * 4096; const unsigned xo_ = (unsigned)r_ * 4096u; \
            R0 = LD16(xb_, xo_ + cA); R1 = LD16(xb_, xo_ + cB); R2 = LD16(xb_, xo_ + cB + 16u); R3 = LD16(xb_, xo_ + cC); R4 = LD16(xb_, xo_ + cC + 16u); \
            rdt = *(const bf16_t*)((const char*)Z + ((unsigned)r_ * (EVEN_IN * 2u) + cD)); } \
        if constexpr (MIX == 1) { const unsigned zo_ = (unsigned)r_ * (EVEN_IN * 2u); \
            R0 = LD16(Z, zo_ + cA); R1 = LD16(Z, zo_ + cA + 16u); R2 = LD16(Z, zo_ + cB); R3 = LD16(Z, zo_ + cC); \
            const int rb_ = row_of(b, d, (ci) * CH), ra_ = d ? rb_ - r16 : rb_ + r16, rc_ = d ? rb_ - 16 - r16 : rb_ + 16 + r16; \
            R4 = LD16(Z, (unsigned)ra_ * (EVEN_IN * 2u) + cD); R5 = LD16(Z, (unsigned)rc_ * (EVEN_IN * 2u) + cD); } \
        if constexpr (MIX == 2) { const unsigned zo_ = (unsigned)r_ * (ODD_IN * 2u); \
            R0 = LD16(Z, zo_ + cA); R1 = LD16(Z, zo_ + cA + 16u); R2 = LD16(Z, zo_ + cB); R3 = LD16(Z, zo_ + cB + 16u); R4 = LD16(Z, zo_ + cC); R5 = LD16(Z, zo_ + cC + 16u); } } while (0)
    CK_LOAD(0);
    for (int ci = 0; ci < NCH; ++ci) {
        if constexpr (MIX == 0) { dt_ = softplusf_(bf2f(rdt) + dtb); if (j_ == 0) Gf[t_] = dt_ * nega; }
        if constexpr (MIX == 1) {
            const f32x4 z4 = (f32x4){0.f, 0.f, 0.f, 0.f};
            const f32x4 g0 = __builtin_amdgcn_mfma_f32_16x16x32_bf16(__builtin_bit_cast(bf16x8, R4), gwB, z4, 0, 0, 0), g1 = __builtin_amdgcn_mfma_f32_16x16x32_bf16(__builtin_bit_cast(bf16x8, R5), gwB, z4, 0, 0, 0);
            float l0[4], l1[4];
#pragma unroll
            for (int j = 0; j < 4; ++j) { const float a0 = g0[j] + gbl, a1 = g1[j] + gbl;
                l0[j] = __builtin_amdgcn_logf(1.f + exp2f_(fminf(a0 * -1.4426950408889634f, 115.f))) * (-1.f / 16.f);
                l1[j] = __builtin_amdgcn_logf(1.f + exp2f_(fminf(a1 * -1.4426950408889634f, 115.f))) * (-1.f / 16.f); }
#pragma unroll
            for (int j = 1; j < 4; ++j) { l0[j] += l0[j - 1]; l1[j] += l1[j - 1]; }
            float i0 = l0[3], i1 = l1[3];
            { float u0 = __shfl_up(i0, 16), u1 = __shfl_up(i1, 16); if (quad >= 1) { i0 += u0; i1 += u1; }
              u0 = __shfl_up(i0, 32); u1 = __shfl_up(i1, 32); if (quad >= 2) { i0 += u0; i1 += u1; } }
            const float e0 = i0 - l0[3], tot0 = __shfl(i0, 48 + r16), e1 = i1 - l1[3] + tot0;
#pragma unroll
            for (int j = 0; j < 4; ++j) { Gf[(quad * 4 + j) * 64 + 16 * w + r16] = l0[j] + e0; Gf[(16 + quad * 4 + j) * 64 + 16 * w + r16] = l1[j] + e1; } }
        if constexpr (MIX == 2) { float f_[16]; unpack8(R4, f_); unpack8(R5, f_ + 8);
            float k1_[16];
#pragma unroll
            for (int i = 0; i < 16; ++i) { const float lb_ = misc[j_ * 16 + i], sg = sigmoidf_(f_[i]); k1_[i] = (1.f - lb_) * (1.f - sg); f_[i] = __logf(lb_ + (1.f - lb_) * sg); }
            kst0 = pack8(k1_); kst1 = pack8(k1_ + 8);
#pragma unroll
            for (int i = 0; i < 4; ++i) *(f32x4*)(Gf + t_ * 128 + j_ * 16 + 4 * i) = (f32x4){f_[4 * i], f_[4 * i + 1], f_[4 * i + 2], f_[4 * i + 3]}; }
        __syncthreads();
        const int rbase = row_of(b, d, ci * CH); const bool first = first_arrival(ci);
        constexpr int OLD_LD = MIX == 2 ? 1024 : EVEN_IN, OCOL = MIX == 0 ? C0_Y : (MIX == 1 ? C0_O : 0), HW = MIX == 0 ? 64 : 128;
        bf16_t* const obase = MIX == 2 ? Ob : Z;
        unsigned ooff[2][4]; float oldv[NPT][2][4];
#pragma unroll
        for (int tt = 0; tt < 2; ++tt)
#pragma unroll
            for (int j = 0; j < 4; ++j) { const int t = 16 * tt + quad * 4 + j, r = d ? rbase - t : rbase + t; ooff[tt][j] = (unsigned)r * OLD_LD + OCOL + hd * HW + w * NPT * 16 + r16; }
        if (!first) {
#pragma unroll
            for (int i = 0; i < NPT; ++i)
#pragma unroll
                for (int tt = 0; tt < 2; ++tt)
#pragma unroll
                    for (int j = 0; j < 4; ++j) oldv[i][tt][j] = bf2f(obase[ooff[tt][j] + i * 16]);
        } else if constexpr (MIX == 0) {
            const bf16_t* xb = rbase < ML ? xl : xcx - (size_t)ML * 2048;
#pragma unroll
            for (int tt = 0; tt < 2; ++tt)
#pragma unroll
                for (int j = 0; j < 4; ++j) { const int t = 16 * tt + quad * 4 + j, r = d ? rbase - t : rbase + t; oldv[0][tt][j] = dsk * bf2f(xb[(size_t)r * 2048 + hd * 64 + w * 16 + r16]); }
        } else {
#pragma unroll
            for (int i = 0; i < NPT; ++i)
#pragma unroll
                for (int tt = 0; tt < 2; ++tt)
#pragma unroll
                    for (int j = 0; j < 4; ++j) oldv[i][tt][j] = 0.f;
        }
        if constexpr (MIX == 0) { if (gt < 32) { float s_ = 0.f, mine = 0.f;
#pragma unroll 8
                for (int u = 0; u < 32; ++u) { s_ += Gf[u]; if (u == gt) mine = s_; }
                Gf[32 + gt] = mine; } }
        if constexpr (MIX == 2) { constexpr int TP = DK / 8;
            const int n_ = gt % DK, part = gt / DK; float gv[TP];
#pragma unroll
            for (int t = 0; t < TP; ++t) gv[t] = Gf[(part * TP + t) * DK + n_];
#pragma unroll
            for (int t = 1; t < TP; ++t) gv[t] += gv[t - 1];
#pragma unroll
            for (int t = 0; t < TP; ++t) Gf[(part * TP + t) * DK + n_] = gv[t]; }
        if constexpr (MIX != 1) __syncthreads();
        if constexpr (MIX == 0) { const float Gt = Gf[32 + t_], GC = Gf[63], eend = exp2f_(GC - Gt);
            *(u32x4*)(Qt + t_ * QS + j_ * 16) = R3; *(u32x4*)(Qt + t_ * QS + j_ * 16 + 8) = R4;
            *(u32x4*)(Kt + t_ * QS + j_ * 16) = R1; *(u32x4*)(Kt + t_ * QS + j_ * 16 + 8) = R2;
            float f_[16]; unpack8(R1, f_); unpack8(R2, f_ + 8);
#pragma unroll
            for (int i = 0; i < 16; ++i) f_[i] *= eend;
            *(u32x4*)(Kh + t_ * QS + j_ * 16) = pack8(f_); *(u32x4*)(Kh + t_ * QS + j_ * 16 + 8) = pack8(f_ + 8);
            unpack8(R0, f_);
#pragma unroll
            for (int i = 0; i < 8; ++i) f_[i] *= dt_;
            *(u32x4*)(Vs + t_ * VS + j_ * 8) = pack8(f_);
            if (gt == 0) dC[0] = exp2f_(GC); }
        if constexpr (MIX == 1) { float q_[8], k_[8], a_[8];
            const f32x4 g0 = *(const f32x4*)(Gf + t_ * 64 + j_ * 8), g1 = *(const f32x4*)(Gf + t_ * 64 + j_ * 8 + 4), e0 = *(const f32x4*)(Gf + 31 * 64 + j_ * 8), e1 = *(const f32x4*)(Gf + 31 * 64 + j_ * 8 + 4);
            unpack8(R3, q_); unpack8(R2, k_);
#pragma unroll
            for (int i = 0; i < 8; ++i) { const float G = i < 4 ? g0[i & 3] : g1[i & 3], GC = i < 4 ? e0[i & 3] : e1[i & 3];
                q_[i] = q_[i] * 0.125f * exp2f_(G); a_[i] = k_[i] * exp2f_(fminf(-G, 115.f));
                if (t_ == 31) dC[j_ * 8 + i] = exp2f_(GC); }
            *(u32x4*)(Qt + t_ * QS + j_ * 8) = pack8(q_); *(u32x4*)(Kt + t_ * QS + j_ * 8) = pack8(a_);
            *(u32x4*)(Vs + t_ * VS + j_ * 16) = R0; *(u32x4*)(Vs + t_ * VS + j_ * 16 + 8) = R1; }
        if constexpr (MIX == 2) { float q_[16], f_[16], a_[16], c_[16];
            unpack8(R2, q_); unpack8(R3, q_ + 8); unpack8(kst0, f_); unpack8(kst1, f_ + 8);
#pragma unroll
            for (int i = 0; i < 16; ++i) { const float P0 = Gf[15 * 128 + j_ * 16 + i], GC = P0 + Gf[31 * 128 + j_ * 16 + i], G = Gf[t_ * 128 + j_ * 16 + i] + (t_ >= 16 ? P0 : 0.f);
                const float kk = f_[i];
                q_[i] = siluf_(q_[i]) * __expf(G); a_[i] = kk * __expf(-G); c_[i] = kk * __expf(GC - G);
                if (t_ == 31) dC[j_ * 16 + i] = __expf(GC); }
            *(u32x4*)(Qt + t_ * QS + j_ * 16) = pack8(q_); *(u32x4*)(Qt + t_ * QS + j_ * 16 + 8) = pack8(q_ + 8);
            *(u32x4*)(Kt + t_ * QS + j_ * 16) = pack8(a_); *(u32x4*)(Kt + t_ * QS + j_ * 16 + 8) = pack8(a_ + 8);
            *(u32x4*)(Kh + t_ * QS + j_ * 16) = pack8(c_); *(u32x4*)(Kh + t_ * QS + j_ * 16 + 8) = pack8(c_ + 8);
            *(u32x4*)(Vs + t_ * VS + j_ * 16) = R0; *(u32x4*)(Vs + t_ * VS + j_ * 16 + 8) = R1; }
        if (ci + 1 < NCH) CK_LOAD(ci + 1);
        __syncthreads();
        const float* Gs = Gf + 32;
        u32x2 P[3];
#pragma unroll
        for (int tile = 0; tile < 3; ++tile) { const int tt = tile > 0 ? 1 : 0, st = tile == 2 ? 1 : 0;
            f32x4 acc = (f32x4){0.f, 0.f, 0.f, 0.f};
#pragma unroll
            for (int ks = 0; ks < NKS; ++ks) { const bf16x8 a = *(const bf16x8*)(Kt + (16 * st + r16) * QS + 32 * ks + quad * 8), bq = *(const bf16x8*)(Qt + (16 * tt + r16) * QS + 32 * ks + quad * 8);
                acc = __builtin_amdgcn_mfma_f32_16x16x32_bf16(a, bq, acc, 0, 0, 0); }
            const int tl = 16 * tt + r16, s0 = 16 * st + quad * 4;
            if constexpr (SC) { const float gtl = Gs[tl]; const f32x4 gs4 = *(const f32x4*)(Gs + s0);
#pragma unroll
                for (int j = 0; j < 4; ++j) acc[j] = (s0 + j <= tl) ? acc[j] * exp2f_(gtl - gs4[j]) : 0.f; }
            else {
#pragma unroll
                for (int j = 0; j < 4; ++j) acc[j] = (s0 + j <= tl) ? acc[j] : 0.f; }
            P[tile].x = cvt_pk_bf16(acc[0], acc[1]); P[tile].y = cvt_pk_bf16(acc[2], acc[3]); }
        bf16x8 vb[NPT], vb2[NPT];
#pragma unroll
        for (int i = 0; i < NPT; ++i) { const bf16_t* vA = Vs + (quad * 4 + (r16 >> 2)) * VS + (w * NPT + i) * 16 + 4 * (r16 & 3); const bf16_t* vB = Vs + (quad * 8 + (r16 >> 2)) * VS + (w * NPT + i) * 16 + 4 * (r16 & 3);
            vb[i] = tr2(vA, vA + 16 * VS); vb2[i] = tr2(vB, vB + 4 * VS); }
#pragma unroll
        for (int i = 0; i < NPT; ++i) {
            bf16x8 Sb8[NKS];
#pragma unroll
            for (int sl = 0; sl < NKS; ++sl) { u32x4 r; r.x = cvt_pk_bf16(accS[2 * sl][i][0], accS[2 * sl][i][1]); r.y = cvt_pk_bf16(accS[2 * sl][i][2], accS[2 * sl][i][3]);
                r.z = cvt_pk_bf16(accS[2 * sl + 1][i][0], accS[2 * sl + 1][i][1]); r.w = cvt_pk_bf16(accS[2 * sl + 1][i][2], accS[2 * sl + 1][i][3]); Sb8[sl] = __builtin_bit_cast(bf16x8, r); }
#pragma unroll
            for (int tt = 0; tt < 2; ++tt) {
                u32x4 a4; if (tt == 0) { a4.x = P[0].x; a4.y = P[0].y; a4.z = 0u; a4.w = 0u; } else { a4.x = P[1].x; a4.y = P[1].y; a4.z = P[2].x; a4.w = P[2].y; }
                f32x4 acc = __builtin_amdgcn_mfma_f32_16x16x32_bf16(__builtin_bit_cast(bf16x8, a4), vb[i], (f32x4){0.f, 0.f, 0.f, 0.f}, 0, 0, 0);
                f32x4 acc2 = SC ? (f32x4){0.f, 0.f, 0.f, 0.f} : acc;
#pragma unroll
                for (int sl = 0; sl < NKS; ++sl) { const u32x2 lo = *(const u32x2*)(Qt + (16 * tt + r16) * QS + 32 * sl + quad * 4), hi = *(const u32x2*)(Qt + (16 * tt + r16) * QS + 32 * sl + 16 + quad * 4);
                    u32x4 q4; q4.x = lo.x; q4.y = lo.y; q4.z = hi.x; q4.w = hi.y;
                    acc2 = __builtin_amdgcn_mfma_f32_16x16x32_bf16(__builtin_bit_cast(bf16x8, q4), Sb8[sl], acc2, 0, 0, 0); }
                if constexpr (SC) { const f32x4 g4 = *(const f32x4*)(Gs + 16 * tt + quad * 4);
#pragma unroll
                    for (int j = 0; j < 4; ++j) acc[j] = fmaf(exp2f_(g4[j]), acc2[j], acc[j]); }
                else acc = acc2;
#pragma unroll
                for (int j = 0; j < 4; ++j) obase[ooff[tt][j] + i * 16] = f2bf(acc[j] + oldv[i][tt][j]);
            }
        }
        { const bf16_t* kB = (SC ? Kh : Kt) + (quad * 8 + (r16 >> 2)) * QS + 4 * (r16 & 3);
#pragma unroll
            for (int ns = 0; ns < NNS; ++ns) { const bf16x8 ka = tr2(kB + 16 * ns, kB + 16 * ns + 4 * QS);
                f32x4 dc; if constexpr (SC) { const float e = dC[0]; dc = (f32x4){e, e, e, e}; } else dc = *(const f32x4*)(dC + 16 * ns + quad * 4);
#pragma unroll
                for (int i = 0; i < NPT; ++i) { if constexpr (SC) accS[ns][i] = __builtin_amdgcn_mfma_f32_16x16x32_bf16(ka, vb2[i], accS[ns][i] * dc, 0, 0, 0);
                    else accS[ns][i] = __builtin_amdgcn_mfma_f32_16x16x32_bf16(ka, vb2[i], accS[ns][i], 0, 0, 0) * dc; } } }
    }
#undef CK_LOAD
#undef LD16
}

__device__ __forceinline__ void hgrn8_item(const Params& p, unsigned char* smem, int item) {
    constexpr int DK = 128, DV = 128, QS = DK + 8, VS = DV + 8, NKS = DK / 32, NNS = DK / 16;
    const int tid = threadIdx.x, d = item & 1, hd = (item >> 1) & 7, b = item >> 4, t_ = tid >> 4, j_ = tid & 15;
    const int w = tid >> 6, lane = tid & 63, r16 = lane & 15, quad = lane >> 4;
    bf16_t* Qt = (bf16_t*)smem; bf16_t* Kt = Qt + 32 * QS; bf16_t* Kh = Kt + 32 * QS; bf16_t* Vs = Kh + 32 * QS;
    float* Gf = (float*)(Vs + 32 * VS); float* dC = Gf + 32 * DK; float* lbs = dC + DK;
    const unsigned kh_addr = (unsigned)(size_t)Kh, vs_addr = (unsigned)(size_t)Vs;
    bf16_t* Z1 = (bf16_t*)(p.ws + OFF_Z);
    __syncthreads();
    if (tid < 128) { const float l0 = p.in[20][d * 1024 + hd * 128 + tid], l1 = p.in[20][2048 + d * 1024 + hd * 128 + tid]; lbs[tid] = 1.f / (1.f + expf(l0 - l1)); }
    __syncthreads();
    f32x4 accS[NNS];
#pragma unroll
    for (int a = 0; a < NNS; ++a) accS[a] = (f32x4){0.f, 0.f, 0.f, 0.f};
    u32x4 Rv, Rq, Rf, kst = (u32x4){0u, 0u, 0u, 0u};
    const unsigned hO = (C1_F + d * 1024 + hd * 128 + w * 16 + r16) * 2u;
    const unsigned hV = (C1_I + hd * 128 + j_ * 8) * 2u, hQ = (C1_Q + hd * 128 + j_ * 8) * 2u, hF = (C1_F + d * 1024 + hd * 128 + j_ * 8) * 2u;
#define H8_LOAD(ci) do { const unsigned zo_ = (unsigned)row_of(b, d, (ci) * CH + t_) * (ODD_IN * 2u); \
        Rv = *(const u32x4*)((const char*)Z1 + (zo_ + hV)); Rq = *(const u32x4*)((const char*)Z1 + (zo_ + hQ)); Rf = *(const u32x4*)((const char*)Z1 + (zo_ + hF)); } while (0)
    H8_LOAD(0);
    for (int ci = 0; ci < NCH; ++ci) {
        { float f_[8], k1_[8]; unpack8(Rf, f_);
#pragma unroll
            for (int i = 0; i < 8; ++i) { const float lb_ = lbs[j_ * 8 + i], sg = sigmoidf_(f_[i]); k1_[i] = (1.f - lb_) * (1.f - sg); f_[i] = __builtin_amdgcn_logf(lb_ + (1.f - lb_) * sg); }
            kst = pack8(k1_);
            *(f32x4*)(Gf + t_ * 128 + j_ * 8) = (f32x4){f_[0], f_[1], f_[2], f_[3]}; *(f32x4*)(Gf + t_ * 128 + j_ * 8 + 4) = (f32x4){f_[4], f_[5], f_[6], f_[7]}; }
        __syncthreads();
        { const int n_ = tid & 127, part = tid >> 7; float gv[8];
#pragma unroll
            for (int t = 0; t < 8; ++t) gv[t] = Gf[(part * 8 + t) * DK + n_];
#pragma unroll
            for (int t = 1; t < 8; ++t) gv[t] += gv[t - 1];
#pragma unroll
            for (int t = 0; t < 8; ++t) Gf[(part * 8 + t) * DK + n_] = gv[t]; }
        __syncthreads();
        { float q_[8], k_[8], a_[8];
            f32x4 g0 = *(const f32x4*)(Gf + t_ * 128 + j_ * 8), g1 = *(const f32x4*)(Gf + t_ * 128 + j_ * 8 + 4), e0 = (f32x4){0.f, 0.f, 0.f, 0.f}, e1 = e0;
#pragma unroll
            for (int pp = 0; pp < 4; ++pp) { const f32x4 a0 = *(const f32x4*)(Gf + (pp * 8 + 7) * 128 + j_ * 8), a1 = *(const f32x4*)(Gf + (pp * 8 + 7) * 128 + j_ * 8 + 4);
                e0 = e0 + a0; e1 = e1 + a1; if (pp < (t_ >> 3)) { g0 = g0 + a0; g1 = g1 + a1; } }
            unpack8(Rq, q_); unpack8(kst, k_);
#pragma unroll
            for (int i = 0; i < 8; ++i) { const float G = i < 4 ? g0[i & 3] : g1[i & 3], GC = i < 4 ? e0[i & 3] : e1[i & 3];
                q_[i] = q_[i] * exp2f_(G); a_[i] = k_[i] * exp2f_(-G);
                if (t_ == 31) dC[j_ * 8 + i] = exp2f_(GC); }
            *(u32x4*)(Qt + t_ * QS + j_ * 8) = pack8(q_); *(u32x4*)(Kt + t_ * QS + j_ * 8) = pack8(a_);
            *(u32x4*)(Vs + t_ * VS + j_ * 8) = Rv; }
        if (ci + 1 < NCH) H8_LOAD(ci + 1);
        __syncthreads();
        u32x2 P[3];
#pragma unroll
        for (int tile = 0; tile < 3; ++tile) { const int tt = tile > 0 ? 1 : 0, st = tile == 2 ? 1 : 0;
            f32x4 acc = (f32x4){0.f, 0.f, 0.f, 0.f};
#pragma unroll
            for (int ks = 0; ks < NKS; ++ks) { const bf16x8 a = *(const bf16x8*)(Kt + (16 * st + r16) * QS + 32 * ks + quad * 8), bq = *(const bf16x8*)(Qt + (16 * tt + r16) * QS + 32 * ks + quad * 8);
                acc = __builtin_amdgcn_mfma_f32_16x16x32_bf16(a, bq, acc, 0, 0, 0); }
            const int tl = 16 * tt + r16, s0 = 16 * st + quad * 4;
#pragma unroll
            for (int j = 0; j < 4; ++j) acc[j] = (s0 + j <= tl) ? acc[j] : 0.f;
            P[tile].x = cvt_pk_bf16(acc[0], acc[1]); P[tile].y = cvt_pk_bf16(acc[2], acc[3]); }
        const int rbase = row_of(b, d, ci * CH);
        const bf16_t* vA = Vs + (quad * 4 + (r16 >> 2)) * VS + w * 16 + 4 * (r16 & 3); const bf16_t* vB = Vs + (quad * 8 + (r16 >> 2)) * VS + w * 16 + 4 * (r16 & 3);
        const bf16x8 vb = tr2(vA, vA + 16 * VS), vb2 = tr2(vB, vB + 4 * VS);
        bf16x8 Sb8[NKS];
#pragma unroll
        for (int sl = 0; sl < NKS; ++sl) { u32x4 r; r.x = cvt_pk_bf16(accS[2 * sl][0], accS[2 * sl][1]); r.y = cvt_pk_bf16(accS[2 * sl][2], accS[2 * sl][3]);
            r.z = cvt_pk_bf16(accS[2 * sl + 1][0], accS[2 * sl + 1][1]); r.w = cvt_pk_bf16(accS[2 * sl + 1][2], accS[2 * sl + 1][3]); Sb8[sl] = __builtin_bit_cast(bf16x8, r); }
#pragma unroll
        for (int tt = 0; tt < 2; ++tt) {
            u32x4 a4; if (tt == 0) { a4.x = P[0].x; a4.y = P[0].y; a4.z = 0u; a4.w = 0u; } else { a4.x = P[1].x; a4.y = P[1].y; a4.z = P[2].x; a4.w = P[2].y; }
            f32x4 acc = __builtin_amdgcn_mfma_f32_16x16x32_bf16(__builtin_bit_cast(bf16x8, a4), vb, (f32x4){0.f, 0.f, 0.f, 0.f}, 0, 0, 0);
#pragma unroll
            for (int sl = 0; sl < NKS; ++sl) { const u32x2 lo = *(const u32x2*)(Qt + (16 * tt + r16) * QS + 32 * sl + quad * 4), hi = *(const u32x2*)(Qt + (16 * tt + r16) * QS + 32 * sl + 16 + quad * 4);
                u32x4 q4; q4.x = lo.x; q4.y = lo.y; q4.z = hi.x; q4.w = hi.y;
                acc = __builtin_amdgcn_mfma_f32_16x16x32_bf16(__builtin_bit_cast(bf16x8, q4), Sb8[sl], acc, 0, 0, 0); }
#pragma unroll
            for (int j = 0; j < 4; ++j) { const int t = 16 * tt + quad * 4 + j, r = d ? rbase - t : rbase + t;
                *(bf16_t*)((char*)Z1 + ((unsigned)r * (ODD_IN * 2u) + hO)) = f2bf(acc[j]); }
        }
        { const bf16_t* kB = Kt + (quad * 8 + (r16 >> 2)) * QS + 4 * (r16 & 3);
#pragma unroll
            for (int ns = 0; ns < NNS; ++ns) { const bf16x8 ka = tr2(kB + 16 * ns, kB + 16 * ns + 4 * QS); const f32x4 dc = *(const f32x4*)(dC + 16 * ns + quad * 4);
                accS[ns] = __builtin_amdgcn_mfma_f32_16x16x32_bf16(ka, vb2, accS[ns], 0, 0, 0) * dc; } }
    }
#undef H8_LOAD
}

template <int n> __device__ __forceinline__ void ldv(const float* p, float* o) {
    if (n == 2) { const f32x2 v = *(const f32x2*)p; o[0] = v.x; o[1] = v.y; }
    else { const f32x4 v = *(const f32x4*)p; o[0] = v.x; o[1] = v.y; o[2] = v.z; o[3] = v.w;
        if (n == 8) { const f32x4 v2 = *(const f32x4*)(p + 4); o[4] = v2.x; o[5] = v2.y; o[6] = v2.z; o[7] = v2.w; } }
}
__device__ __forceinline__ void s5_item(const Params& p, unsigned char* smem, int bitem) {
    constexpr int XS = 136, XB = 32 * XS * 2;
    const int tid = threadIdx.x, lane = tid & 63, wave = tid >> 6, sq = wave & 3, role = wave >> 2, d = (sq >> 1) & 1, r16 = lane & 15, quad = lane >> 4;
    const int pair = bitem * 2 + (sq & 1), b = pair / 24, g = pair % 24;
    const bf16_t* Z1 = (const bf16_t*)(p.ws + OFF_Z);
    bf16_t* YS = d ? (bf16_t*)(p.ws + OFF_H) : (bf16_t*)(p.ws + OFF_YS5);
    unsigned char* xbase = smem + sq * 2 * XB;
    bf16x8* bAl = (bf16x8*)(smem + 8 * XB + sq * 8192);
    float lre = 0.f, lim = 0.f, xr = 0.f, xi = 0.f;
    bf16x8 cB[4];
#pragma unroll
    for (int ks = 0; ks < 4; ++ks) cB[ks] = (bf16x8){0, 0, 0, 0, 0, 0, 0, 0};
    __syncthreads();
    if (role == 0) {
        const float delta = expf(p.in[24][d * 24 + g]);
        float* ztab = (float*)xbase;
        { const float are = p.in[22][(d * 24 + g) * 64 + lane], aim = p.in[23][(d * 24 + g) * 64 + lane], mag = expf(are * delta); lre = mag * cosf(aim * delta); lim = mag * sinf(aim * delta);
            const float den = are * are + aim * aim; ztab[2 * lane] = ((lre - 1.f) * are + lim * aim) / den; ztab[2 * lane + 1] = (lim * are - (lre - 1.f) * aim) / den; }
        __builtin_amdgcn_wave_barrier();
#pragma unroll 1
        for (int pt = 0; pt < 8; ++pt) { const int pp = 16 * pt + r16, st = pp >> 1, part = pp & 1; float f[8];
            const float zr = ztab[2 * st], zi = ztab[2 * st + 1];
#pragma unroll
            for (int j = 0; j < 8; ++j) { const int c = (quad & 1) * 8 + j; const float br = p.in[25][((size_t)g * 64 + st) * 16 + c], bi = p.in[26][((size_t)g * 64 + st) * 16 + c];
                const float v = part ? (zr * bi + zi * br) : (zr * br - zi * bi); f[j] = quad < 2 ? v : 0.f; }
            const u32x4 pk = pack8(f); bAl[pt * 64 + lane] = __builtin_bit_cast(bf16x8, pk); }
    } else {
#pragma unroll
        for (int ks = 0; ks < 4; ++ks) { float f[8];
#pragma unroll
            for (int j = 0; j < 8; ++j) { const int k = ks * 32 + quad * 8 + j, st = k >> 1; f[j] = (k & 1) ? -p.in[28][((size_t)g * 16 + r16) * 64 + st] : p.in[27][((size_t)g * 16 + r16) * 64 + st]; }
            const u32x4 pk = pack8(f); cB[ks] = __builtin_bit_cast(bf16x8, pk); }
    }
    __syncthreads();
    u32x4 ru0 = (u32x4){0u, 0u, 0u, 0u}, ru1 = ru0;
#define S5_LOAD(ci) do { const int rb_ = row_of(b, d, (ci) * CH); const int r0_ = d ? rb_ - r16 : rb_ + r16, r1_ = d ? rb_ - 16 - r16 : rb_ + 16 + r16; \
        ru0 = *(const u32x4*)(Z1 + (size_t)r0_ * ODD_IN + C1_U + g * 16 + (quad & 1) * 8); ru1 = *(const u32x4*)(Z1 + (size_t)r1_ * ODD_IN + C1_U + g * 16 + (quad & 1) * 8); } while (0)
    if (role == 0) S5_LOAD(0);
    for (int it = 0; it <= NCH; ++it) {
        if (role == 0) {
            if (it < NCH) { const int ci = it; bf16_t* xs = (bf16_t*)(xbase + (ci & 1) * XB);
                const u32x4 z4 = (u32x4){0u, 0u, 0u, 0u};
                const bf16x8 u0 = __builtin_bit_cast(bf16x8, quad < 2 ? ru0 : z4), u1 = __builtin_bit_cast(bf16x8, quad < 2 ? ru1 : z4);
                if (ci + 1 < NCH) S5_LOAD(ci + 1);
                bf16x8 bAr[8];
#pragma unroll
                for (int pt = 0; pt < 8; ++pt) bAr[pt] = bAl[pt * 64 + lane];
#pragma unroll
                for (int pt = 0; pt < 8; ++pt) {
                    const f32x4 d0 = __builtin_amdgcn_mfma_f32_16x16x32_bf16(bAr[pt], u0, (f32x4){0.f, 0.f, 0.f, 0.f}, 0, 0, 0);
                    const f32x4 d1 = __builtin_amdgcn_mfma_f32_16x16x32_bf16(bAr[pt], u1, (f32x4){0.f, 0.f, 0.f, 0.f}, 0, 0, 0);
                    u32x2 w0, w1; w0.x = cvt_pk_bf16(d0[0], d0[1]); w0.y = cvt_pk_bf16(d0[2], d0[3]); w1.x = cvt_pk_bf16(d1[0], d1[1]); w1.y = cvt_pk_bf16(d1[2], d1[3]);
                    *(u32x2*)(xs + r16 * XS + 16 * pt + quad * 4) = w0; *(u32x2*)(xs + (16 + r16) * XS + 16 * pt + quad * 4) = w1; }
                __builtin_amdgcn_wave_barrier();
#pragma unroll 1
                for (int t8 = 0; t8 < CH; t8 += 8) { unsigned bv[8], xv[8];
#pragma unroll
                    for (int t = 0; t < 8; ++t) bv[t] = *(const unsigned*)(xs + (t8 + t) * XS + 2 * lane);
#pragma unroll
                    for (int t = 0; t < 8; ++t) { float br, bi; unpack2(bv[t], br, bi);
                        const float nr = fmaf(lre, xr, fmaf(-lim, xi, br)), ni = fmaf(lre, xi, fmaf(lim, xr, bi)); xr = nr; xi = ni; xv[t] = cvt_pk_bf16(xr, xi); }
#pragma unroll
                    for (int t = 0; t < 8; ++t) *(unsigned*)(xs + (t8 + t) * XS + 2 * lane) = xv[t]; }
            }
        } else {
            if (it >= 1) { const int ci = it - 1; const bf16_t* xs = (const bf16_t*)(xbase + (ci & 1) * XB);
                const int rbase = row_of(b, d, ci * CH);
                if (rbase < ML) {
#pragma unroll
                    for (int tile = 0; tile < 2; ++tile) {
                        f32x4 acc = (f32x4){0.f, 0.f, 0.f, 0.f};
#pragma unroll
                        for (int ks = 0; ks < 4; ++ks) { const bf16x8 a = *(const bf16x8*)(xs + (tile * 16 + r16) * XS + ks * 32 + quad * 8); acc = __builtin_amdgcn_mfma_f32_16x16x32_bf16(a, cB[ks], acc, 0, 0, 0); }
#pragma unroll
                        for (int j = 0; j < 4; ++j) { const int t = tile * 16 + quad * 4 + j, r = d ? rbase - t : rbase + t; *(bf16_t*)((char*)YS + ((unsigned)r * 768u + (unsigned)(g * 16 + r16) * 2u)) = f2bf(acc[j]); }
                    } }
            }
        }
        lds_barrier();
    }
#undef S5_LOAD
}

__device__ __forceinline__ void prep_late(const Params& p, unsigned char* smem, int blk, int nblk) {
    const int tid = threadIdx.x, lane = tid & 63, wave = tid >> 6, gw = blk * 8 + wave, ngw = nblk * 8;
    float* scr = (float*)smem + wave * (64 * 33);
    unsigned char* ws = p.ws;
    transpose_job(p.in[18], 2048, 1024, (bf16_t*)(ws + OFF_WT_OUT0), scr, gw, ngw, lane);
    transpose_job(p.in[33], 1024, 4096, (bf16_t*)(ws + OFF_WT_W1_0), scr, gw, ngw, lane);
    transpose_job(p.in[34], 4096, 1024, (bf16_t*)(ws + OFF_WT_W2_0), scr, gw, ngw, lane);
    transpose_job(p.in[19], 1024, ODD_IN, (bf16_t*)(ws + OFF_WT_IN1), scr, gw, ngw, lane);
    transpose_job(p.in[32], 1408, 1024, (bf16_t*)(ws + OFF_WT_OUT1), scr, gw, ngw, lane);
    transpose_job(p.in[33] + 1024 * 4096, 1024, 4096, (bf16_t*)(ws + OFF_WT_W1_1), scr, gw, ngw, lane);
    transpose_job(p.in[34] + 4096 * 1024, 4096, 1024, (bf16_t*)(ws + OFF_WT_W2_1), scr, gw, ngw, lane);
    transpose_job(p.in[30], 384, 384, (bf16_t*)(ws + OFF_WT_GLU), scr, gw, ngw, lane);
    zero_rows((bf16_t*)(ws + OFF_WT_IN1) + (size_t)ODD_IN * 1024, (size_t)(ODD_PAD - ODD_IN) * 1024, blk, nblk);
    zero_rows((bf16_t*)(ws + OFF_WT_GLU) + (size_t)384 * 384, (size_t)(512 - 384) * 384, blk, nblk);
}
__device__ __forceinline__ void phase_scan0(const Params& p, unsigned char* smem) {
    if ((int)gridDim.x > 192) { if ((int)blockIdx.x >= 192) prep_late(p, smem, (int)blockIdx.x - 192, (int)gridDim.x - 192); }
    else prep_late(p, smem, (int)blockIdx.x, (int)gridDim.x);
    for (int item = blockIdx.x; item < 192; item += gridDim.x) { if (item < 128) chunk_item<0>(p, smem, item); else chunk_item<1>(p, smem, item - 128); __syncthreads(); }
}
__device__ __forceinline__ void phase_scan1(const Params& p, unsigned char* smem) {
    for (int item = blockIdx.x; item < 96 + 128; item += gridDim.x) { if (item < 96) s5_item(p, smem, item); else hgrn8_item(p, smem, item - 96); __syncthreads(); }
}

__device__ __forceinline__ void phase_finish0(const Params& p) {
    const int lane = threadIdx.x & 63, gw = blockIdx.x * 8 + (threadIdx.x >> 6), ngw = gridDim.x * 8;
    bf16_t* Z = (bf16_t*)(p.ws + OFF_Z);
    float nws[16], nwg[16];
#pragma unroll
    for (int i = 0; i < 16; ++i) { nws[i] = p.in[14][lane * 16 + i]; nwg[i] = p.in[17][(lane & 7) * 16 + i]; }
    for (int r0 = gw * 2; r0 < MT; r0 += ngw * 2) {
        u32x4 L[2][8];
#pragma unroll
        for (int q = 0; q < 2; ++q) { const bf16_t* zr = Z + (size_t)(r0 + q) * EVEN_IN;
            L[q][0] = *(const u32x4*)(zr + C0_Y + lane * 16); L[q][1] = *(const u32x4*)(zr + C0_Y + lane * 16 + 8);
            L[q][2] = *(const u32x4*)(zr + C0_Z + lane * 16); L[q][3] = *(const u32x4*)(zr + C0_Z + lane * 16 + 8);
            L[q][4] = *(const u32x4*)(zr + C0_O + lane * 16); L[q][5] = *(const u32x4*)(zr + C0_O + lane * 16 + 8);
            L[q][6] = *(const u32x4*)(zr + C0_R + lane * 16); L[q][7] = *(const u32x4*)(zr + C0_R + lane * 16 + 8); }
#pragma unroll
        for (int q = 0; q < 2; ++q) { bf16_t* zr = Z + (size_t)(r0 + q) * EVEN_IN;
            float y[16], z[16], o[16], rr[16];
            unpack8(L[q][0], y); unpack8(L[q][1], y + 8); unpack8(L[q][2], z); unpack8(L[q][3], z + 8);
            unpack8(L[q][4], o); unpack8(L[q][5], o + 8); unpack8(L[q][6], rr); unpack8(L[q][7], rr + 8);
            float s1 = 0.f, s2 = 0.f;
#pragma unroll
            for (int i = 0; i < 16; ++i) { y[i] *= siluf_(z[i]); s1 = fmaf(y[i], y[i], s1); s2 = fmaf(o[i], o[i], s2); }
            s1 += __shfl_xor(s1, 1); s1 += __shfl_xor(s1, 2); s1 += __shfl_xor(s1, 4); s1 += __shfl_xor(s1, 8);
            s2 += __shfl_xor(s2, 1); s2 += __shfl_xor(s2, 2); s2 += __shfl_xor(s2, 4);
            const float r1 = rsqrtf(s1 * (1.f / 256.f) + EPS), r2 = rsqrtf(s2 * (1.f / 128.f) + EPS);
#pragma unroll
            for (int i = 0; i < 16; ++i) { y[i] = y[i] * r1 * nws[i]; o[i] = o[i] * r2 * nwg[i] * siluf_(rr[i]); }
            *(u32x4*)(zr + C0_MIX + lane * 16) = pack8(y); *(u32x4*)(zr + C0_MIX + lane * 16 + 8) = pack8(y + 8);
            *(u32x4*)(zr + C0_MIX + 1024 + lane * 16) = pack8(o); *(u32x4*)(zr + C0_MIX + 1024 + lane * 16 + 8) = pack8(o + 8); }
    }
}
__device__ __forceinline__ void phase_finish1(const Params& p) {
    const int lane = threadIdx.x & 63, gw = blockIdx.x * 8 + (threadIdx.x >> 6), ngw = gridDim.x * 8;
    bf16_t* Z1 = (bf16_t*)(p.ws + OFF_Z);
    bf16_t* YS = (bf16_t*)(p.ws + OFF_YS5);
    float nwh[16], dsk[6];
#pragma unroll
    for (int i = 0; i < 16; ++i) nwh[i] = p.in[21][(lane & 7) * 16 + i];
#pragma unroll
    for (int i = 0; i < 6; ++i) dsk[i] = p.in[29][lane * 6 + i];
    for (int r = gw; r < ML; r += ngw) {
        bf16_t* zr = Z1 + (size_t)r * ODD_IN;
        float o[16], gg[16];
        { float ob[16]; unpack8(*(const u32x4*)(zr + C1_F + lane * 16), o); unpack8(*(const u32x4*)(zr + C1_F + lane * 16 + 8), o + 8);
            unpack8(*(const u32x4*)(zr + C1_F + 1024 + lane * 16), ob); unpack8(*(const u32x4*)(zr + C1_F + 1024 + lane * 16 + 8), ob + 8);
#pragma unroll
            for (int i = 0; i < 16; ++i) o[i] += ob[i]; }
        unpack8(*(const u32x4*)(zr + C1_G + lane * 16), gg); unpack8(*(const u32x4*)(zr + C1_G + lane * 16 + 8), gg + 8);
        float s2 = 0.f;
#pragma unroll
        for (int i = 0; i < 16; ++i) s2 = fmaf(o[i], o[i], s2);
        s2 += __shfl_xor(s2, 1); s2 += __shfl_xor(s2, 2); s2 += __shfl_xor(s2, 4);
        const float r2 = rsqrtf(s2 * (1.f / 128.f) + EPS);
#pragma unroll
        for (int i = 0; i < 16; ++i) o[i] = o[i] * r2 * nwh[i] * siluf_(gg[i]);
        unsigned* yp = (unsigned*)(YS + (size_t)r * 384 + lane * 6); const unsigned* up = (const unsigned*)(zr + C1_U + lane * 6);
        const unsigned* ybp = (const unsigned*)((const bf16_t*)(p.ws + OFF_H) + (size_t)r * 384 + lane * 6);
        float yv[6], uv[6];
#pragma unroll
        for (int i = 0; i < 3; ++i) { float b0, b1; unpack2(yp[i], yv[2 * i], yv[2 * i + 1]); unpack2(ybp[i], b0, b1); yv[2 * i] += b0; yv[2 * i + 1] += b1; unpack2(up[i], uv[2 * i], uv[2 * i + 1]); }
#pragma unroll
        for (int i = 0; i < 6; ++i) yv[i] = gelu_tanh(fmaf(dsk[i], uv[i], yv[i]));
#pragma unroll
        for (int i = 0; i < 3; ++i) yp[i] = cvt_pk_bf16(yv[2 * i], yv[2 * i + 1]);
        *(u32x4*)(zr + lane * 16) = pack8(o); *(u32x4*)(zr + lane * 16 + 8) = pack8(o + 8);
    }
}

#define XB_TMO      128
#define XB_XCNT(j)  (256  + 64 * (j))
#define XB_XSUB(j)  (1280 + 64 * (j))
#define XB_XGEN(j)  (2304 + 64 * (j))
#define XB_TOP      3328
#define XB_TOPGEN   3392
#define XCD_BAR_WORDS 3456
#define XB_SPIN_CAP (1u << 18)

__device__ __forceinline__ unsigned xb_ld(unsigned* p)              { return __hip_atomic_load(p, __ATOMIC_RELAXED, __HIP_MEMORY_SCOPE_AGENT); }
__device__ __forceinline__ unsigned xb_add(unsigned* p, unsigned v) { return __hip_atomic_fetch_add(p, v, __ATOMIC_RELAXED, __HIP_MEMORY_SCOPE_AGENT); }
__device__ __forceinline__ unsigned xb_xcc_id() { return (unsigned)__builtin_amdgcn_s_getreg((3 << 11) | 20) & 0xFu; }
#define XB_SPIN(cond, bar) do { unsigned _sp = 0; while (cond) { __builtin_amdgcn_s_sleep(1); \
    if ((++_sp & 255u) == 0u) { if (xb_ld(&(bar)[XB_TMO])) break; if (_sp > XB_SPIN_CAP) { atomicAdd(&(bar)[XB_TMO], 1u); break; } } } } while (0)

struct XcdBarrier {
    unsigned* bar; unsigned x;
    volatile LAS unsigned* st;
};

__device__ __forceinline__ XcdBarrier xcd_barrier_post(unsigned* bar, volatile LAS unsigned* st) {
    XcdBarrier b; b.bar = bar; b.x = xb_xcc_id(); b.st = st;
    if (threadIdx.x == 0) (void)xb_add(&bar[XB_XCNT(b.x)], 1u);
    return b;
}
__device__ __forceinline__ void xcd_barrier_complete(unsigned* bar, unsigned x, unsigned& nloc, unsigned& nx) {
    const unsigned G = gridDim.x * gridDim.y * gridDim.z;
    unsigned sum, cnt, mine, sp = 0u;
    for (;;) {
        sum = 0u; cnt = 0u; mine = 0u;
#pragma unroll
        for (unsigned j = 0; j < 16; ++j) { const unsigned c = xb_ld(&bar[XB_XCNT(j)]); sum += c; cnt += (c > 0u) ? 1u : 0u; mine = (j == x) ? c : mine; }
        if (sum == G) break;
        __builtin_amdgcn_s_sleep(1);
        if ((++sp & 255u) == 0u) { if (xb_ld(&bar[XB_TMO])) break; if (sp > XB_SPIN_CAP) { atomicAdd(&bar[XB_TMO], 1u); break; } }
    }
    nloc = mine > 0u ? mine : 1u; nx = cnt > 0u ? cnt : 1u;
}

__device__ __forceinline__ void xcd_barrier(const XcdBarrier& b) {
    asm volatile("s_waitcnt vmcnt(0)" ::: "memory");
    __syncthreads();
    if (threadIdx.x == 0) {
        unsigned* bar = b.bar;
        __builtin_amdgcn_s_waitcnt(0);
        unsigned nloc = b.st[0], nx = b.st[1];
        if (nloc == 0u) { xcd_barrier_complete(bar, b.x, nloc, nx); b.st[0] = nloc; b.st[1] = nx; }
        const unsigned old = xb_add(&bar[XB_XSUB(b.x)], 1u);
        const unsigned gen = old / nloc;
        if (old + 1u == (gen + 1u) * nloc) {
            __builtin_amdgcn_fence(__ATOMIC_RELEASE, "agent");
            asm volatile("s_waitcnt vmcnt(0)" ::: "memory");
            const unsigned og = xb_add(&bar[XB_TOP], 1u);
            const unsigned tg = og / nx;
            if (og + 1u == (tg + 1u) * nx) xb_add(&bar[XB_TOPGEN], 1u);
            else XB_SPIN(xb_ld(&bar[XB_TOPGEN]) == tg, bar);
            __builtin_amdgcn_fence(__ATOMIC_ACQUIRE, "agent");
            xb_add(&bar[XB_XGEN(b.x)], 1u);
            asm volatile("s_waitcnt vmcnt(0)" ::: "memory");
        } else {
            XB_SPIN(xb_ld(&bar[XB_XGEN(b.x)]) == gen, bar);
            __builtin_amdgcn_fence(__ATOMIC_ACQUIRE, "agent");
            asm volatile("s_waitcnt vmcnt(0)" ::: "memory");
        }
    }
    __syncthreads();
}

__global__ __launch_bounds__(512, 2) void mega(Params p) {
    extern __shared__ __attribute__((aligned(16))) unsigned char smem[];
    cg::grid_group grid = cg::this_grid();
    unsigned char* ws = p.ws;
    LAS unsigned char* lds = (LAS unsigned char*)smem;
    float* modp = (float*)(ws + OFF_MOD);
    float* xc = (float*)(ws + OFF_XC);
    bf16_t* H = (bf16_t*)(ws + OFF_H);
    bf16_t* Z = (bf16_t*)(ws + OFF_Z);
    const float* x_in = p.in[0]; const float* ctx_in = p.in[2];
    volatile LAS unsigned* bst = (volatile LAS unsigned*)(LAS unsigned char*)(lds + LDS_MAIN);
    XcdBarrier xb; xb.bar = (unsigned*)(ws + OFF_BAR); xb.x = 0; xb.st = bst;
    if (p.ph_hi - p.ph_lo > 1) { if (threadIdx.x < 2) bst[threadIdx.x] = 0u; __syncthreads(); xb = xcd_barrier_post((unsigned*)(ws + OFF_BAR), bst); }
    if (p.ph_hi < 0) grid.sync();
#define PHASE(ph, ...) if (p.ph_lo <= (ph) && (ph) < p.ph_hi) { __VA_ARGS__; if ((ph) + 1 < p.ph_hi) xcd_barrier(xb); }
    PHASE(0, phase_prep(p, smem))
    PHASE(1, phase_norm<false>(x_in, ctx_in, p.in[6], modp + 0 * 1024, modp + 1 * 1024, H, nullptr, MT))
    PHASE(2, { pg8::EpiBf16<0> E{Z, EVEN_IN, EVEN_IN}; pg8::gemm_phase(lds, H, 1024, (const bf16_t*)(ws + OFF_WT_IN0), MT, EVEN_PAD, 1024, E); })
    PHASE(3, phase_conv(p))
    PHASE(4, phase_scan0(p, smem))
    PHASE(5, phase_finish0(p))
    PHASE(6, { pg8::EpiResid E{x_in, ctx_in, p.out, xc, modp + 2 * 1024}; pg8::gemm_phase(lds, Z + C0_MIX, EVEN_IN, (const bf16_t*)(ws + OFF_WT_OUT0), MT, 1024, 2048, E); })
    PHASE(7, phase_norm<false>(p.out, xc, p.in[7], modp + 3 * 1024, modp + 4 * 1024, H, nullptr, MT))
    PHASE(8, { pg8::EpiBf16<1> E{Z, 4096, 4096}; pg8::gemm_phase(lds, H, 1024, (const bf16_t*)(ws + OFF_WT_W1_0), MT, 4096, 1024, E); })
    PHASE(9, { pg8::EpiResid E{p.out, xc, p.out, xc, modp + 5 * 1024}; pg8::gemm_phase(lds, Z, 4096, (const bf16_t*)(ws + OFF_WT_W2_0), MT, 1024, 4096, E); })
    PHASE(10, phase_norm<false>(p.out, xc, p.in[6] + 1024, modp + 9 * 6144 + 0 * 1024, modp + 9 * 6144 + 1 * 1024, H, nullptr, MT))
    PHASE(11, { pg8::EpiBf16<2> E{Z, ODD_IN, ODD_IN}; pg8::gemm_phase(lds, H, 1024, (const bf16_t*)(ws + OFF_WT_IN1), MT, ODD_PAD, 1024, E); })
    PHASE(12, phase_scan1(p, smem))
    PHASE(13, phase_finish1(p))
    PHASE(14, { pg8::EpiGlu E{(const bf16_t*)(ws + OFF_YS5), Z, p.in[31]}; pg8::gemm_phase(lds, (const bf16_t*)(ws + OFF_YS5), 384, (const bf16_t*)(ws + OFF_WT_GLU), ML, 512, 384, E); })
    PHASE(15, { pg8::EpiResid E{p.out, xc, p.out, xc, modp + 9 * 6144 + 2 * 1024}; pg8::gemm_phase(lds, Z, ODD_IN, (const bf16_t*)(ws + OFF_WT_OUT1), ML, 1024, 1408, E); })
    PHASE(16, phase_norm<false>(p.out, xc, p.in[7] + 1024, modp + 9 * 6144 + 3 * 1024, modp + 9 * 6144 + 4 * 1024, H, nullptr, ML))
    PHASE(17, { pg8::EpiBf16<1> E{Z, 4096, 4096}; pg8::gemm_phase(lds, H, 1024, (const bf16_t*)(ws + OFF_WT_W1_1), ML, 4096, 1024, E); })
    PHASE(18, { pg8::EpiResid E{p.out, xc, p.out, xc, modp + 9 * 6144 + 5 * 1024}; pg8::gemm_phase(lds, Z, 4096, (const bf16_t*)(ws + OFF_WT_W2_1), ML, 1024, 4096, E); })
    PHASE(19, phase_norm<true>(p.out, xc, p.in[35], nullptr, nullptr, nullptr, p.out, ML))
#undef PHASE
}

extern "C" void kernel_launch(void* const* d_in, const int* in_sizes, int n_in, void* d_out, int out_size, void* d_ws, size_t ws_size, hipStream_t stream) {
    static int grid = 0;
    if (grid == 0) {
        if (n_in != 36 || out_size != ML * DM || ws_size < WS_TOTAL) { fprintf(stderr, "kernel_launch: unexpected shapes: n_in %d out %d ws %zu (need %zu)\n", n_in, out_size, ws_size, (size_t)WS_TOTAL); grid = -1; return; }
        int dev = 0, cus = 0, per_cu = 0;
        hipGetDevice(&dev); hipDeviceGetAttribute(&cus, hipDeviceAttributeMultiprocessorCount, dev);
        if (hipFuncSetAttribute((const void*)mega, hipFuncAttributeMaxDynamicSharedMemorySize, LDS_BYTES) != hipSuccess) { fprintf(stderr, "kernel_launch: hipFuncSetAttribute failed\n"); grid = -1; return; }
        hipOccupancyMaxActiveBlocksPerMultiprocessor(&per_cu, (const void*)mega, 512, LDS_BYTES);
        if (per_cu < 1) fprintf(stderr, "kernel_launch: occupancy query says %d blocks per CU\n", per_cu);
        (void)hipGetLastError();
        grid = cus > 0 ? cus : 256;
    }
    if (grid < 0) return;
    Params p{};
    for (int i = 0; i < 36; ++i) p.in[i] = (const float*)d_in[i];
    p.out = (float*)d_out; p.ws = (unsigned char*)d_ws;
#if MK_MODE == 0
    if (hipMemsetAsync((unsigned char*)d_ws + OFF_BAR, 0, 3456 * 4, stream) != hipSuccess) { fprintf(stderr, "kernel_launch: memset of the barrier words failed\n"); return; }
    p.ph_lo = 0; p.ph_hi = NPH;
    void* args[] = {&p};
    hipError_t e = hipLaunchCooperativeKernel((const void*)mega, dim3(grid), dim3(512), args, LDS_BYTES, stream);
    if (e != hipSuccess) fprintf(stderr, "cooperative launch failed: %s (grid %d)\n", hipGetErrorString(e), grid);
#else
    for (int ph = 0; ph < NPH; ++ph) { p.ph_lo = ph; p.ph_hi = ph + 1; hipLaunchKernelGGL(mega, dim3(grid), dim3(512), LDS_BYTES, stream, p); }
#endif
}
```
